# Optimizing an MI355X kernel written in HIP

```python
import math
import jax, jax.numpy as jnp
from jax import lax
import numpy as np

D_MODEL = 2048
BATCH = 1
SEQ = 16384
DEPTH = 4
DEC_BATCH = 2
DEC_SEQ = 4096
PAST_LEN = 128

D_HY = D_MODEL // 4
D_S5 = D_MODEL // 4
D_ML = D_MODEL - D_HY - D_S5
MIX_W = D_HY + D_S5 + D_ML
HY_ORDER = 2
HY_EMB = 33
HY_BANDS = (HY_EMB - 1) // 2
HY_FILT = 64
HY_FAST_DECAY = 0.3
HY_SLOW_DECAY = 1.5
HY_TARGET = 1e-2
S5_GROUP = 16
S5_G = D_S5 // S5_GROUP
S5_P = 64
S5_DT_MIN = 1e-3
S5_DT_MAX = 1e-1
ML_HEADS = 4
ML_DH = D_ML // ML_HEADS
ML_CHUNK = 64
D_FF = 4 * D_MODEL
CONV_W = 3
N_CONV = 3 * D_HY + 2 * D_ML
P_IN = N_CONV + D_S5 + 2 * D_ML + 4 * ML_HEADS
EPS = 1e-6
F32 = jnp.float32

kernel_name = "hymba_style_hyena_s5_mlstm_encoder"


def rms_norm(x, g):
    xf = x.astype(F32)
    y = xf * lax.rsqrt(jnp.mean(xf * xf, axis=-1, keepdims=True) + EPS)
    return (y * g.astype(F32)).astype(x.dtype)


def short_conv(x, w, b):
    L = x.shape[1]
    half = CONV_W // 2
    xp = jnp.pad(x, ((0, 0), (half, CONV_W - 1 - half), (0, 0)))
    out = b
    for j in range(CONV_W):
        out = out + xp[:, j:j + L] * w[j]
    return out


def hyena_filters(L, w1, b1, freq, w2, b2, w3):
    t = jnp.linspace(0.0, 1.0, L, dtype=F32)[:, None]
    w = 2.0 * math.pi * jnp.arange(L, dtype=F32)[:, None] / L
    f = jnp.linspace(1e-4, HY_BANDS - 1, HY_BANDS, dtype=F32)[None, :]
    z = jnp.concatenate([t, jnp.cos(f * w), -jnp.sin(f * w)], axis=-1)
    fr = freq.astype(F32)
    h = jnp.sin(fr * (z @ w1.astype(F32) + b1.astype(F32)))
    h = jnp.sin(fr * (h @ w2.astype(F32) + b2.astype(F32)))
    h = (h @ w3.astype(F32)).reshape(L, HY_ORDER, 2, D_HY)
    deltas = jnp.abs(jnp.linspace(math.log(HY_TARGET) / HY_SLOW_DECAY,
                                  math.log(HY_TARGET) / HY_FAST_DECAY, D_HY, dtype=F32))
    h = h * jnp.exp(-t * deltas)[:, None, None, :]
    fwd = h[:, :, 0]
    bwd = h[1:, :, 1][::-1]
    k = jnp.concatenate([fwd, jnp.zeros((1, HY_ORDER, D_HY), F32), bwd], axis=0)
    k = k * lax.rsqrt(jnp.sum(k * k, axis=0, keepdims=True) + EPS)
    return jnp.fft.rfft(k, axis=0)


def hyena_mixer(hy, kf, skip):
    L = hy.shape[1]
    v, x1, x2 = jnp.split(hy.astype(F32), 3, axis=-1)
    z = v
    for o, gate in enumerate((x1, x2)):
        zf = jnp.fft.rfft(z, n=2 * L, axis=1)
        conv = jnp.fft.irfft(zf * kf[None, :, o], n=2 * L, axis=1)[:, :L]
        z = gate * (conv + skip[o].astype(F32) * z)
    return z


def _lin_combine(e1, e2):
    a1, b1 = e1
    a2, b2 = e2
    return a1 * a2, a2 * b1 + b2


def s5_direction(u, lam_re, lam_im, log_dt, b_re, b_im, c_re, c_im, reverse):
    lam = lax.complex(jnp.minimum(lam_re.astype(F32), -1e-4), lam_im.astype(F32))
    dt = jnp.exp(log_dt.astype(F32))[:, None]
    a_bar = jnp.exp(lam * dt)
    b_bar = ((a_bar - 1.0) / lam)[..., None] * lax.complex(b_re.astype(F32), b_im.astype(F32))
    bu = jnp.einsum('blgh,gph->blgp', u.astype(jnp.complex64), b_bar)
    a = jnp.broadcast_to(a_bar, bu.shape)
    _, xs = lax.associative_scan(_lin_combine, (a, bu), axis=1, reverse=reverse)
    c = lax.complex(c_re.astype(F32), c_im.astype(F32))
    return jnp.real(jnp.einsum('blgp,ghp->blgh', xs, c))


def s5_mixer(u, lam_re, lam_im, log_dt, b_re, b_im, c_re, c_im, d, glu_w, glu_b):
    B_, L, _ = u.shape
    uf = u.astype(F32)
    ug = uf.reshape(B_, L, S5_G, S5_GROUP)
    y = s5_direction(ug, lam_re[0], lam_im[0], log_dt[0], b_re[0], b_im[0], c_re[0], c_im[0], False)
    y = y + s5_direction(ug, lam_re[1], lam_im[1], log_dt[1], b_re[1], b_im[1], c_re[1], c_im[1], True)
    y = y.reshape(B_, L, D_S5) + d.astype(F32) * uf
    g = jax.nn.gelu(y)
    val, gate = jnp.split(g @ glu_w.astype(F32) + glu_b.astype(F32), 2, axis=-1)
    return val * jax.nn.sigmoid(gate)


def mlstm_direction(q, k, v, ig, fg):
    B_, NH, L, DH = q.shape
    nc = L // ML_CHUNK

    def chunks(t):
        return jnp.moveaxis(t.reshape((B_, NH, nc, ML_CHUNK) + t.shape[3:]), 2, 0)

    b = jnp.cumsum(chunks(jax.nn.log_sigmoid(fg)), axis=-1)
    causal = jnp.tril(jnp.ones((ML_CHUNK, ML_CHUNK), dtype=bool))

    def step(carry, inp):
        c, n, m = carry
        qc, kc, vc, ic, bc = inp
        g = bc + m[..., None]
        dmat = bc[..., :, None] - bc[..., None, :] + ic[..., None, :]
        dmat = jnp.where(causal, dmat, -jnp.inf)
        mt = jnp.maximum(g, jnp.max(dmat, axis=-1))
        inter = jnp.exp(g - mt)
        s = jnp.einsum('bhtd,bhsd->bhts', qc, kc) * jnp.exp(dmat - mt[..., None])
        num = inter[..., None] * jnp.einsum('bhtk,bhkv->bhtv', qc, c) + jnp.einsum('bhts,bhsv->bhtv', s, vc)
        den = inter * jnp.einsum('bhtk,bhk->bht', qc, n) + jnp.sum(s, axis=-1)
        h = num / jnp.maximum(jnp.abs(den), jnp.exp(-mt))[..., None]
        b_last = bc[..., -1]
        a = b_last[..., None] - bc + ic
        m_new = jnp.maximum(b_last + m, jnp.max(a, axis=-1))
        decay = jnp.exp(b_last + m - m_new)
        wgt = jnp.exp(a - m_new[..., None])
        c = decay[..., None, None] * c + jnp.einsum('bhtk,bhtv->bhkv', kc * wgt[..., None], vc)
        n = decay[..., None] * n + jnp.einsum('bht,bhtk->bhk', wgt, kc)
        return (c, n, m_new), h

    init = (jnp.zeros((B_, NH, DH, DH), F32), jnp.zeros((B_, NH, DH), F32), jnp.zeros((B_, NH), F32))
    _, h = lax.scan(step, init, (chunks(q), chunks(k), chunks(v), chunks(ig), b))
    return jnp.moveaxis(h, 0, 2).reshape(B_, NH, L, DH)


def mlstm_mixer(qk, v, o, gates, gate_b, norm_g):
    B_, L, _ = v.shape
    qk = jax.nn.silu(qk.astype(F32))

    def heads(t):
        return t.reshape(B_, L, ML_HEADS, ML_DH).transpose(0, 2, 1, 3)

    q = heads(qk[..., :D_ML])
    k = heads(qk[..., D_ML:]) * (ML_DH ** -0.5)
    vv = heads(v.astype(F32))
    g = (gates.astype(F32) + gate_b.astype(F32).reshape(-1)).reshape(B_, L, 4, ML_HEADS).transpose(2, 0, 3, 1)
    h_f = mlstm_direction(q, k, vv, g[0], g[1])
    flip = lambda t: jnp.flip(t, axis=2)
    h_b = flip(mlstm_direction(flip(q), flip(k), flip(vv), flip(g[2]), flip(g[3])))
    h = (h_f + h_b).transpose(0, 2, 1, 3)
    h = rms_norm(h, norm_g.reshape(ML_HEADS, ML_DH)).reshape(B_, L, D_ML)
    return h * jax.nn.sigmoid(o.astype(F32))


def encoder_layer(x, ln_g, w_in, conv_w, conv_b, hy_w1, hy_b1, hy_freq, hy_w2, hy_b2, hy_w3, hy_skip,
                  s5_lam_re, s5_lam_im, s5_log_dt, s5_b_re, s5_b_im, s5_c_re, s5_c_im, s5_d,
                  s5_glu_w, s5_glu_b, ml_gate_b, group_norm, w_out, mlp_w1, mlp_w2):
    L = x.shape[1]
    h = rms_norm(x, ln_g[0])
    proj = h @ w_in
    conv = short_conv(proj[..., :N_CONV], conv_w, conv_b)
    hy_in = conv[..., :3 * D_HY]
    qk = conv[..., 3 * D_HY:]
    s = N_CONV
    u_s5 = proj[..., s:s + D_S5]
    s += D_S5
    v_ml = proj[..., s:s + D_ML]
    s += D_ML
    o_ml = proj[..., s:s + D_ML]
    s += D_ML
    g_ml = proj[..., s:]
    kf = hyena_filters(L, hy_w1, hy_b1, hy_freq, hy_w2, hy_b2, hy_w3)
    y_hy = rms_norm(hyena_mixer(hy_in, kf, hy_skip), group_norm[:D_HY])
    y_s5 = rms_norm(s5_mixer(u_s5, s5_lam_re, s5_lam_im, s5_log_dt, s5_b_re, s5_b_im, s5_c_re, s5_c_im,
                             s5_d, s5_glu_w, s5_glu_b), group_norm[D_HY:D_HY + D_S5])
    y_ml = mlstm_mixer(qk, v_ml, o_ml, g_ml, ml_gate_b, group_norm[D_HY + D_S5:])
    mix = jnp.concatenate([y_hy, y_s5, y_ml], axis=-1).astype(x.dtype) @ w_out
    x = x + rms_norm(mix, ln_g[1])
    h = rms_norm(x, ln_g[2])
    f = jnp.square(jax.nn.relu(h @ mlp_w1)) @ mlp_w2
    return x + rms_norm(f, ln_g[3])


def setup_inputs(seed: int = 0) -> dict:
    key = jax.random.key(seed)
    ks = jax.random.split(key, 32)

    def nrm(k, shape, scale):
        return scale * jax.random.normal(k, shape, F32)

    n_idx = jnp.arange(S5_P, dtype=F32)
    gb = nrm(ks[23], (DEPTH, 4, ML_HEADS), 0.1)
    gb = gb + jnp.array([0.0, 1.0, 0.0, 1.0], F32)[:, None] * jnp.linspace(3.0, 6.0, ML_HEADS, dtype=F32)[None, :]
    return {
        "x_prompt": nrm(ks[0], (BATCH, SEQ, D_MODEL), 1.0),
        "x_sample": nrm(ks[1], (DEC_BATCH, DEC_SEQ, D_MODEL), 1.0),
        "ln_g": 1.0 + nrm(ks[2], (DEPTH, 4, D_MODEL), 0.05),
        "w_in": nrm(ks[3], (DEPTH, D_MODEL, P_IN), D_MODEL ** -0.5),
        "conv_w": nrm(ks[4], (DEPTH, CONV_W, N_CONV), CONV_W ** -0.5),
        "conv_b": nrm(ks[5], (DEPTH, N_CONV), 0.02),
        "hy_w1": nrm(ks[6], (DEPTH, HY_EMB, HY_FILT), HY_EMB ** -0.5),
        "hy_b1": nrm(ks[7], (DEPTH, HY_FILT), 0.1),
        "hy_freq": 1.0 + nrm(ks[8], (DEPTH, HY_FILT), 0.05),
        "hy_w2": nrm(ks[9], (DEPTH, HY_FILT, HY_FILT), HY_FILT ** -0.5),
        "hy_b2": nrm(ks[10], (DEPTH, HY_FILT), 0.1),
        "hy_w3": nrm(ks[11], (DEPTH, HY_FILT, HY_ORDER * 2 * D_HY), HY_FILT ** -0.5),
        "hy_skip": nrm(ks[12], (DEPTH, HY_ORDER, D_HY), 0.3),
        "s5_lam_re": -0.5 + nrm(ks[13], (DEPTH, 2, S5_G, S5_P), 0.01),
        "s5_lam_im": math.pi * n_idx + nrm(ks[14], (DEPTH, 2, S5_G, S5_P), 0.01),
        "s5_log_dt": jax.random.uniform(ks[15], (DEPTH, 2, S5_G), F32, math.log(S5_DT_MIN), math.log(S5_DT_MAX)),
        "s5_b_re": nrm(ks[16], (DEPTH, 2, S5_G, S5_P, S5_GROUP), (2 * S5_GROUP) ** -0.5),
        "s5_b_im": nrm(ks[17], (DEPTH, 2, S5_G, S5_P, S5_GROUP), (2 * S5_GROUP) ** -0.5),
        "s5_c_re": nrm(ks[18], (DEPTH, 2, S5_G, S5_GROUP, S5_P), S5_P ** -0.5),
        "s5_c_im": nrm(ks[19], (DEPTH, 2, S5_G, S5_GROUP, S5_P), S5_P ** -0.5),
        "s5_d": nrm(ks[20], (DEPTH, D_S5), 1.0),
        "s5_glu_w": nrm(ks[21], (DEPTH, D_S5, 2 * D_S5), D_S5 ** -0.5),
        "s5_glu_b": nrm(ks[22], (DEPTH, 2 * D_S5), 0.02),
        "ml_gate_b": gb,
        "group_norm": 1.0 + nrm(ks[24], (DEPTH, MIX_W), 0.05),
        "w_out": nrm(ks[25], (DEPTH, MIX_W, D_MODEL), MIX_W ** -0.5),
        "mlp_w1": nrm(ks[26], (DEPTH, D_MODEL, D_FF), D_MODEL ** -0.5),
        "mlp_w2": nrm(ks[27], (DEPTH, D_FF, D_MODEL), D_FF ** -0.5),
    }


def reference(x_prompt, x_sample, ln_g, w_in, conv_w, conv_b, hy_w1, hy_b1, hy_freq, hy_w2, hy_b2, hy_w3,
              hy_skip, s5_lam_re, s5_lam_im, s5_log_dt, s5_b_re, s5_b_im, s5_c_re, s5_c_im, s5_d,
              s5_glu_w, s5_glu_b, ml_gate_b, group_norm, w_out, mlp_w1, mlp_w2):
    params = (ln_g, w_in, conv_w, conv_b, hy_w1, hy_b1, hy_freq, hy_w2, hy_b2, hy_w3, hy_skip,
              s5_lam_re, s5_lam_im, s5_log_dt, s5_b_re, s5_b_im, s5_c_re, s5_c_im, s5_d,
              s5_glu_w, s5_glu_b, ml_gate_b, group_norm, w_out, mlp_w1, mlp_w2)
    y_prompt = x_prompt
    y_sample = x_sample
    for l in range(DEPTH):
        lp = [p[l] for p in params]
        y_prompt = encoder_layer(y_prompt, *lp)
        y_sample = encoder_layer(y_sample, *lp)
    return (y_prompt, y_sample)
```

```cpp
#include <hip/hip_runtime.h>
#include <hip/hip_cooperative_groups.h>
#include <cstdio>
namespace cg = cooperative_groups;
#ifndef PROBE
#define PROBE 0
#endif
__device__ __forceinline__ int launder_tid() { int t = (int)threadIdx.x; asm volatile("" : "+v"(t)); return t; }
__device__ __forceinline__ int launder_bid() { int t = (int)blockIdx.x; asm volatile("" : "+s"(t)); return t; }
namespace pg8 {
#define PG8_LAS __attribute__((address_space(3)))
typedef unsigned short bf16_t;
typedef short bf16x8 __attribute__((ext_vector_type(8)));
typedef float f32x4 __attribute__((ext_vector_type(4)));
typedef unsigned u32x4 __attribute__((ext_vector_type(4)));
constexpr int BM = 256, BK = 64, HALF = 128, HTB = HALF * BK * 2  , STAGE_BYTES = 8 * HTB, NXCD = 8, WGM = 8;

__host__ __device__ __forceinline__ int lds_byte(int r, int c) { const int st = (r >> 4) * 2 + (c >> 5), rr = r & 15, cc = c & 31, ob = rr * 64 + cc * 2; return st * 1024 + (ob ^ (((ob >> 9) & 1) << 5)); }
__host__ __device__ __forceinline__ void stage_rc(int b, int& R, int& C) { const int st = b / 1024, sb = b % 1024, swz = sb ^ (((sb >> 9) & 1) << 5); R = (st >> 1) * 16 + swz / 64; C = (st & 1) * 32 + (swz % 64) / 2; }
__host__ __device__ __forceinline__ int perm32(int rho) { const int n = rho >> 4, i = rho & 15; return 8 * (i >> 2) + 4 * n + (i & 3); }

struct Unit { int pm, pn; };
struct Gemm { const bf16_t* A; const bf16_t* Bt; int M, N, K; };

struct StaticOrder {
    int nM, nN, nwg, G, c;
    __host__ __device__ void init(int M, int N, int G_, int c_) { nM = M / BM; nN = N / BM; nwg = nM * nN; G = G_; c = c_; }
    __host__ __device__ bool next(int i, Unit& u) const {
        const long L = (long)i * G + c; if (L >= nwg) return false;
        int wgid = (int)L; { const int q = nwg / NXCD, r = nwg % NXCD, xcd = wgid % NXCD, off = wgid / NXCD; wgid = (xcd < r ? xcd * (q + 1) : r * (q + 1) + (xcd - r) * q) + off; }
        const int nig = WGM * nN, gid = wgid / nig, fm = gid * WGM, gsz = (nM - fm) < WGM ? (nM - fm) : WGM;
        u.pm = fm + ((wgid % nig) % gsz); u.pn = (wgid % nig) / gsz; return true;
    }
    __device__ __forceinline__ void a_ready(const Unit&) const {}
    __device__ __forceinline__ void done(const Unit&) const {}
};
__device__ __forceinline__ unsigned cvt_pk_bf16(float lo, float hi) { unsigned r; asm volatile("v_cvt_pk_bf16_f32 %0, %1, %2" : "=v"(r) : "v"(lo), "v"(hi)); return r; }
typedef float f32x2 __attribute__((ext_vector_type(2)));
__device__ __forceinline__ f32x2 gelu_pk(f32x2 v) {
    const f32x2 av = __builtin_elementwise_abs(v), d = av * 0.2316418882f + 1.0f;
    f32x2 t; t.x = __builtin_amdgcn_rcpf(d.x); t.y = __builtin_amdgcn_rcpf(d.y);
    f32x2 q = t * 0.5307027145f + (-0.7265760135f); q = q * t + 0.7107068705f; q = q * t + (-0.142248368f); q = q * t + 0.127414796f; q = q * t;
    const f32x2 s = (v * v) * (-0.72134752044f);
    f32x2 e; e.x = __builtin_amdgcn_exp2f(s.x); e.y = __builtin_amdgcn_exp2f(s.y);
    const f32x2 m = v * (q * e), r = v - m;
    f32x2 o; o.x = v.x < 0.f ? m.x : r.x; o.y = v.y < 0.f ? m.y : r.y; return o;
}

struct EpiF32 {
    static constexpr bool PERM = false, AFTER_DRAIN = false;
    float* C; int ldc; const float* bias;
    __device__ __forceinline__ void operator()(const f32x4 (&acc)[2][2][4][2], const Unit& u, int wr, int wc, int fr, int fq) const {
        const int row0 = u.pm * BM + wr * 64 + fr, col0 = u.pn * BM + wc * 32 + 4 * fq;
        f32x4 bv[2][2];
#pragma unroll
        for (int bj = 0; bj < 2; ++bj)
#pragma unroll
            for (int n = 0; n < 2; ++n) bv[bj][n] = bias ? *(const f32x4*)(bias + col0 + bj * HALF + n * 16) : (f32x4){0.f, 0.f, 0.f, 0.f};
#pragma unroll
        for (int ai = 0; ai < 2; ++ai)
#pragma unroll
            for (int m = 0; m < 4; ++m) { float* rowp = C + (size_t)(row0 + ai * HALF + m * 16) * ldc + col0;
#pragma unroll
                for (int bj = 0; bj < 2; ++bj)
#pragma unroll
                    for (int n = 0; n < 2; ++n) *(f32x4*)(rowp + bj * HALF + n * 16) = acc[ai][bj][m][n] + bv[bj][n]; }
    }
};
template <int ACT  > struct EpiBf16 {
    static constexpr bool PERM = true, AFTER_DRAIN = false;
    bf16_t* O; int ldc; const float* bias; int split_cols; size_t split_stride;
    __device__ __forceinline__ void operator()(const f32x4 (&acc)[2][2][4][2], const Unit& u, int wr, int wc, int fr, int fq) const {
        const int row0 = u.pm * BM + wr * 64 + fr; int colt = u.pn * BM; bf16_t* base = O;
        if (split_cols) { const int t = colt / split_cols; base += (size_t)t * split_stride; colt -= t * split_cols; }
        const int col0 = colt + wc * 32 + 8 * fq, bcol0 = u.pn * BM + wc * 32 + 8 * fq;
        f32x4 bv[2][2];
#pragma unroll
        for (int bj = 0; bj < 2; ++bj)
#pragma unroll
            for (int n = 0; n < 2; ++n) bv[bj][n] = bias ? *(const f32x4*)(bias + bcol0 + bj * HALF + 4 * n) : (f32x4){0.f, 0.f, 0.f, 0.f};
#pragma unroll
        for (int ai = 0; ai < 2; ++ai)
#pragma unroll
            for (int m = 0; m < 4; ++m) { bf16_t* rowp = base + (size_t)(row0 + ai * HALF + m * 16) * ldc + col0;
#pragma unroll
                for (int bj = 0; bj < 2; ++bj) { f32x4 v0 = acc[ai][bj][m][0] + bv[bj][0], v1 = acc[ai][bj][m][1] + bv[bj][1];
                    if (ACT == 1) { f32x2 a = gelu_pk((f32x2){v0[0], v0[1]}), b = gelu_pk((f32x2){v0[2], v0[3]}), c = gelu_pk((f32x2){v1[0], v1[1]}), d = gelu_pk((f32x2){v1[2], v1[3]});
                        v0 = (f32x4){a.x, a.y, b.x, b.y}; v1 = (f32x4){c.x, c.y, d.x, d.y}; }
                    if (ACT == 2) {
#pragma unroll
                        for (int j = 0; j < 4; ++j) { v0[j] = 0.5f * v0[j] * (1.0f + erff(v0[j] * 0.70710678f)); v1[j] = 0.5f * v1[j] * (1.0f + erff(v1[j] * 0.70710678f)); } }
                    u32x4 w; w.x = cvt_pk_bf16(v0[0], v0[1]); w.y = cvt_pk_bf16(v0[2], v0[3]); w.z = cvt_pk_bf16(v1[0], v1[1]); w.w = cvt_pk_bf16(v1[2], v1[3]);
                    *(u32x4*)(rowp + bj * HALF) = w; } }
    }
};
template <int ACT> struct EpiBf16X {
    static constexpr bool PERM = true, AFTER_DRAIN = false;
    bf16_t* O; int ldc;
    __device__ __forceinline__ void operator()(const f32x4 (&acc)[2][2][4][2], const Unit& u, int wr, int wc, int fr, int fq) const {
        const int row0 = u.pm * BM + wr * 64 + fr; const int col0 = u.pn * BM + wc * 32 + 8 * fq;
#pragma unroll
        for (int ai = 0; ai < 2; ++ai)
#pragma unroll
            for (int m = 0; m < 4; ++m) { bf16_t* rowp = O + (size_t)(row0 + ai * HALF + m * 16) * ldc + col0;
#pragma unroll
                for (int bj = 0; bj < 2; ++bj) { f32x4 v0 = acc[ai][bj][m][0], v1 = acc[ai][bj][m][1];
                    if (ACT == 3) {
#pragma unroll
                        for (int j = 0; j < 4; ++j) { float a = fmaxf(v0[j], 0.f), b = fmaxf(v1[j], 0.f); v0[j] = a * a; v1[j] = b * b; } }
                    u32x4 w; w.x = cvt_pk_bf16(v0[0], v0[1]); w.y = cvt_pk_bf16(v0[2], v0[3]); w.z = cvt_pk_bf16(v1[0], v1[1]); w.w = cvt_pk_bf16(v1[2], v1[3]);
                    *(u32x4*)(rowp + bj * HALF) = w; } }
    }
};
struct EpiGlu {
    static constexpr bool PERM = false, AFTER_DRAIN = false;
    float* C; int ldc; const float* bias;
    __device__ __forceinline__ void operator()(const f32x4 (&acc)[2][2][4][2], const Unit& u, int wr, int wc, int fr, int fq) const {
        const int row0 = u.pm * BM + wr * 64 + fr, col0 = u.pn * HALF + wc * 32 + 4 * fq;
#pragma unroll
        for (int n = 0; n < 2; ++n) { const f32x4 bv = *(const f32x4*)(bias + col0 + n * 16), bg = *(const f32x4*)(bias + 512 + col0 + n * 16);
#pragma unroll
            for (int ai = 0; ai < 2; ++ai)
#pragma unroll
                for (int m = 0; m < 4; ++m) { float* p = C + (size_t)(row0 + ai * HALF + m * 16) * ldc + col0 + n * 16;
                    const f32x4 v = acc[ai][0][m][n] + bv, g = acc[ai][1][m][n] + bg; f32x4 o;
#pragma unroll
                    for (int j = 0; j < 4; ++j) o[j] = v[j] / (1.0f + __expf(-g[j]));
                    *(f32x4*)p = o; } }
    }
};
template <class Epi, class Sched>
__device__ __forceinline__ void gemm_phase(PG8_LAS unsigned char* lds, const Gemm g, const Sched& S, const Epi& E) {
    const int tid = launder_tid(), wid = __builtin_amdgcn_readfirstlane(tid >> 6), lane = tid & 63, wr = wid >> 2, wc = wid & 3, fr = lane & 15, fq = lane >> 4;
    const int K = g.K, nt = K / BK;
    unsigned voffA[2], voffB[2];
#pragma unroll
    for (int i = 0; i < 2; ++i) { int R, C; stage_rc(tid * 16 + i * 8192, R, C); const int Rb = Epi::PERM ? ((R & ~31) + perm32(R & 31)) : R;
        voffA[i] = (unsigned)(R * K + C) * 2u; voffB[i] = (unsigned)(Rb * K + C) * 2u; }
    const size_t kstep = (size_t)(BK * 2);
    const size_t hstep = (size_t)HALF * K * 2;
    const size_t tstep = 2 * hstep;
    const unsigned ldsw = (unsigned)wid * 1024u;
    const int aoff = lds_byte(wr * 64 + fr, fq * 8), boff = lds_byte(wc * 32 + fr, fq * 8);
#define PG8_SA(b, h) (((b) * 2 + (h)) * HTB)
#define PG8_SB(b, h) ((4 + (b) * 2 + (h)) * HTB)
#define PG8_STAGE(bufoff, gbase, voff) do { _Pragma("unroll") for (int _i = 0; _i < 2; ++_i) \
        __builtin_amdgcn_global_load_lds((const unsigned*)((const char*)(gbase) + (voff)[_i]), (PG8_LAS unsigned*)(lds + (bufoff) + ldsw + _i * 8192), 16, 0, 0); } while (0)
#define PG8_LDA(dst, b, h) do { _Pragma("unroll") for (int m = 0; m < 4; ++m) _Pragma("unroll") for (int k = 0; k < 2; ++k) dst[m][k] = *(const PG8_LAS bf16x8*)(lds + PG8_SA(b, h) + aoff + m * 2048 + k * 1024); } while (0)
#define PG8_LDB(dst, b, h) do { _Pragma("unroll") for (int n = 0; n < 2; ++n) _Pragma("unroll") for (int k = 0; k < 2; ++k) dst[n][k] = *(const PG8_LAS bf16x8*)(lds + PG8_SB(b, h) + boff + n * 2048 + k * 1024); } while (0)
#define PG8_MMA(ai, bj, At, Bt) do { __builtin_amdgcn_s_setprio(1); _Pragma("unroll") for (int m = 0; m < 4; ++m) _Pragma("unroll") for (int n = 0; n < 2; ++n) _Pragma("unroll") for (int k = 0; k < 2; ++k) \
        acc[ai][bj][m][n] = __builtin_amdgcn_mfma_f32_16x16x32_bf16(Bt[n][k], At[m][k], acc[ai][bj][m][n], 0, 0, 0); __builtin_amdgcn_s_setprio(0); } while (0)
#define PG8_WAIT_V(n) asm volatile("s_waitcnt vmcnt(" #n ")" ::: "memory")
#define PG8_WAIT_L(n) asm volatile("s_waitcnt lgkmcnt(" #n ")" ::: "memory")
#define PG8_BAR __builtin_amdgcn_s_barrier()
#define PG8_SCHED __builtin_amdgcn_sched_barrier(0)
    Unit cur, nxt; int ui = 0;
    if (!S.next(0, cur)) return;
    f32x4 acc[2][2][4][2];
#pragma unroll
    for (int a = 0; a < 2; ++a)
#pragma unroll
        for (int b = 0; b < 2; ++b)
#pragma unroll
            for (int m = 0; m < 4; ++m)
#pragma unroll
                for (int n = 0; n < 2; ++n) acc[a][b][m][n] = (f32x4){0.f, 0.f, 0.f, 0.f};
    bf16x8 At[4][2], B0[2][2], B1[2][2];
    const char* cA = (const char*)g.A + (size_t)cur.pm * tstep; const char* cB = (const char*)g.Bt + (size_t)cur.pn * tstep;
    S.a_ready(cur);
    PG8_STAGE(PG8_SB(0, 0), cB, voffB); PG8_STAGE(PG8_SA(0, 0), cA, voffA); PG8_STAGE(PG8_SB(0, 1), cB + hstep, voffB); PG8_STAGE(PG8_SA(0, 1), cA + hstep, voffA);
    if (wr == 1) PG8_BAR;
    PG8_WAIT_V(4); PG8_BAR;
    PG8_STAGE(PG8_SB(1, 0), cB + kstep, voffB); PG8_STAGE(PG8_SA(1, 0), cA + kstep, voffA); PG8_STAGE(PG8_SB(1, 1), cB + hstep + kstep, voffB);
    PG8_WAIT_V(6); PG8_BAR;
    for (;;) {
        const bool has_next = S.next(ui + 1, nxt);
        const char* nA = has_next ? (const char*)g.A + (size_t)nxt.pm * tstep : cA; const char* nB = has_next ? (const char*)g.Bt + (size_t)nxt.pn * tstep : cB;
        for (int t = 0; t < nt; t += 2) {
            const bool last = (t == nt - 2);
            const char* a1 = cA + (size_t)(t + 1) * kstep;
            const char* a2 = last ? nA : cA + (size_t)(t + 2) * kstep; const char* b2 = last ? nB : cB + (size_t)(t + 2) * kstep;
            const char* a3 = a2 + kstep; const char* b3 = b2 + kstep;
            if (last && has_next) S.a_ready(nxt);
            PG8_LDB(B0, 0, 0); PG8_SCHED; PG8_LDA(At, 0, 0); PG8_STAGE(PG8_SA(1, 1), a1 + hstep, voffA);
            PG8_WAIT_L(8); PG8_BAR; PG8_WAIT_L(0); PG8_MMA(0, 0, At, B0); PG8_BAR; PG8_SCHED;
            PG8_LDB(B1, 0, 1); PG8_STAGE(PG8_SB(0, 0), b2, voffB);
            PG8_BAR; PG8_WAIT_L(0); PG8_MMA(0, 1, At, B1); PG8_BAR;
            PG8_LDA(At, 0, 1); PG8_STAGE(PG8_SA(0, 0), a2, voffA);
            PG8_BAR; PG8_WAIT_L(0); PG8_MMA(1, 0, At, B0); PG8_BAR; PG8_SCHED;
            PG8_STAGE(PG8_SB(0, 1), b2 + hstep, voffB);
            PG8_WAIT_V(6); PG8_BAR; PG8_MMA(1, 1, At, B1); PG8_BAR;
            PG8_LDB(B0, 1, 0); PG8_SCHED; PG8_LDA(At, 1, 0); PG8_STAGE(PG8_SA(0, 1), a2 + hstep, voffA);
            PG8_WAIT_L(8); PG8_BAR; PG8_WAIT_L(0); PG8_MMA(0, 0, At, B0); PG8_BAR; PG8_SCHED;
            PG8_LDB(B1, 1, 1); PG8_STAGE(PG8_SB(1, 0), b3, voffB);
            PG8_BAR; PG8_WAIT_L(0); PG8_MMA(0, 1, At, B1); PG8_BAR;
            PG8_LDA(At, 1, 1); PG8_STAGE(PG8_SA(1, 0), a3, voffA);
            PG8_BAR; PG8_WAIT_L(0); PG8_MMA(1, 0, At, B0); PG8_BAR; PG8_SCHED;
            PG8_STAGE(PG8_SB(1, 1), b3 + hstep, voffB);
            PG8_WAIT_V(6); PG8_BAR; PG8_MMA(1, 1, At, B1); PG8_BAR;
        }
        if constexpr (!Epi::AFTER_DRAIN) { E(acc, cur, wr, wc, fr, fq); S.done(cur); }
        if (!has_next) break;
#pragma unroll
        for (int a = 0; a < 2; ++a)
#pragma unroll
            for (int b = 0; b < 2; ++b)
#pragma unroll
                for (int m = 0; m < 4; ++m)
#pragma unroll
                    for (int n = 0; n < 2; ++n) acc[a][b][m][n] = (f32x4){0.f, 0.f, 0.f, 0.f};
        cur = nxt; cA = nA; cB = nB; ++ui;
    }
    PG8_WAIT_V(0);
    if (wr == 0) PG8_BAR;
    PG8_BAR;
    if constexpr (Epi::AFTER_DRAIN) { E.fused(acc, cur, wr, wc, fr, fq, lds, wid, lane); S.done(cur); }
#undef PG8_SA
#undef PG8_SB
#undef PG8_STAGE
#undef PG8_LDA
#undef PG8_LDB
#undef PG8_MMA
#undef PG8_WAIT_V
#undef PG8_WAIT_L
#undef PG8_BAR
#undef PG8_SCHED
}
}

typedef unsigned short bf16_t;
typedef short bf16x8 __attribute__((ext_vector_type(8)));
typedef float f32x4 __attribute__((ext_vector_type(4)));
constexpr int NT = 512;
constexpr int LDS_BYTES = 136 * 1024;
constexpr int TOK = 24576, DM = 2048, PIN = 6160, NP = 6144, DFF = 8192;
constexpr int NLAYER = 4;
constexpr float EPSN = 1e-6f;
constexpr size_t MiB = 1024 * 1024;
constexpr size_t WS_WB = 0;
constexpr size_t WB_WIN = 0, WB_GLU = WB_WIN + (size_t)NP * DM * 2, WB_WOUT = WB_GLU + (size_t)1024 * 512 * 2, WB_W1 = WB_WOUT + (size_t)DM * DM * 2, WB_W2 = WB_W1 + (size_t)DFF * DM * 2;
static_assert(WB_W2 + (size_t)DFF * DM * 2 <= 97 * MiB, "wb");
constexpr size_t WS_H = 97 * MiB;
constexpr size_t WS_P = 193 * MiB;
constexpr size_t WS_TMP = 193 * MiB;
constexpr size_t WS_HID = 385 * MiB;
constexpr size_t WS_HYIN = 481 * MiB;
constexpr size_t WS_QK = 625 * MiB;
constexpr size_t WS_MIX = 625 * MiB;
constexpr size_t WS_MLH = 721 * MiB;
constexpr size_t WS_S5Y = 817 * MiB;
constexpr size_t WS_S5O = 841 * MiB;
constexpr size_t WS_SCR = 889 * MiB;
constexpr size_t WS_H2T = 921 * MiB;
constexpr size_t WS_G = 926 * MiB;
constexpr size_t WS_FIN = 928 * MiB;
constexpr size_t WS_CTR = 935 * MiB;
constexpr size_t WS_HF0 = WS_H;
constexpr size_t WS_HF1 = WS_H + 40 * MiB;
constexpr size_t WS_VT = WS_S5O;
constexpr size_t WS_KT = 936 * MiB;
constexpr size_t WS_SL = 984 * MiB;
constexpr size_t WS_BJ = 1008 * MiB;
constexpr size_t WS_PMJ = WS_BJ + (size_t)8 * 24576 * 4;
constexpr size_t WS_LOC = WS_PMJ + (size_t)8 * 24576 * 4;
constexpr size_t WS_BLML = WS_LOC + (size_t)8 * 24576 * 4;
constexpr size_t WS_WL = WS_BLML + 64 * 1024;
constexpr size_t WS_END = 1012 * MiB;
static_assert(WS_WL + (size_t)8 * 24576 * 4 <= WS_END, "ws map");
constexpr size_t HF_G1 = (size_t)2 * 512 * 16384;

struct Args { const float* in[28]; float* out; unsigned char* ws; int ph_lo, ph_hi; };

typedef __bf16 bf16x2n_t __attribute__((ext_vector_type(2)));
__device__ __forceinline__ unsigned pk2(float lo, float hi) { bf16x2n_t v; v[0] = (__bf16)lo; v[1] = (__bf16)hi; return __builtin_bit_cast(unsigned, v); }
__device__ __forceinline__ bf16_t f2bf(float f) { return __builtin_bit_cast(bf16_t, (__bf16)f); }
__device__ __forceinline__ float bf2f(bf16_t b) { return __uint_as_float(((unsigned)b) << 16); }
__device__ __forceinline__ float bflo(unsigned w) { return __uint_as_float(w << 16); }
__device__ __forceinline__ float bfhi(unsigned w) { return __uint_as_float(w & 0xffff0000u); }
__device__ __forceinline__ float sinr(float x) { return __builtin_amdgcn_sinf(x); }
__device__ __forceinline__ float cosr(float x) { return __builtin_amdgcn_cosf(x); }
__device__ __forceinline__ float my_shfl(float v, int src) { return __int_as_float(__builtin_amdgcn_ds_bpermute(src << 2, __float_as_int(v))); }
__device__ __forceinline__ float shflx(float v, int o, int lane) { return my_shfl(v, lane ^ o); }
__device__ __forceinline__ float my_shfl_up(float v, int o, int lane) { return my_shfl(v, lane - o); }
__device__ __forceinline__ float wave_sum(float v) { const int lane = launder_tid() & 63;
#pragma unroll
    for (int o = 32; o >= 1; o >>= 1) v += shflx(v, o, lane);
    return v; }
__device__ __forceinline__ float wave_max(float v) { const int lane = launder_tid() & 63;
#pragma unroll
    for (int o = 32; o >= 1; o >>= 1) v = fmaxf(v, shflx(v, o, lane));
    return v; }
__device__ __forceinline__ float sigmoidf_(float x) { return 1.0f / (1.0f + __expf(-x)); }
__device__ __forceinline__ bool seq_first(int t) { return t == 0 || t == 16384 || t == 20480; }
__device__ __forceinline__ bool seq_last(int t) { return t == 16383 || t == 20479 || t == 24575; }

__device__ __forceinline__ void cvt_tile(const float* __restrict__ src, int ldsrc, int k0, int srccol0, bf16_t* __restrict__ dst, int K, int n0, float* tl) {
    const int tid = launder_tid();
#pragma unroll
    for (int i = 0; i < 8; ++i) { const int kk = (tid >> 4) + 32 * i, nn4 = (tid & 15) * 4;
        const float4 v = *(const float4*)(src + (size_t)(k0 + kk) * ldsrc + srccol0 + nn4);
        tl[(nn4 + 0) * 257 + kk] = v.x; tl[(nn4 + 1) * 257 + kk] = v.y; tl[(nn4 + 2) * 257 + kk] = v.z; tl[(nn4 + 3) * 257 + kk] = v.w; }
    __syncthreads();
#pragma unroll
    for (int i = 0; i < 4; ++i) { const int item = i * NT + tid, nn = item >> 5, ks = (item & 31) * 8; const float* r = tl + nn * 257 + ks;
      uint4 w; w.x = pk2(r[0], r[1]); w.y = pk2(r[2], r[3]); w.z = pk2(r[4], r[5]); w.w = pk2(r[6], r[7]);
      *(uint4*)(dst + (size_t)(n0 + nn) * K + k0 + ks) = w; }
    __syncthreads();
}
constexpr int CVT_EARLY = 768 + 32 + 256, CVT_ALL = CVT_EARLY + 2048;
__device__ __forceinline__ void convert_tile(const Args& a, int l, int t, float* tl);
constexpr int CVT_WIN = 768;
__device__ void convert_weights(const Args& a, int l, unsigned char* lds) {
    for (int t = launder_bid() + (l == 0 ? 0 : CVT_WIN); t < CVT_EARLY; t += gridDim.x) convert_tile(a, l, t, (float*)lds);
}
__device__ __forceinline__ void convert_tile(const Args& a, int l, int t, float* tl) {
    unsigned char* wb = a.ws + WS_WB;
    const int T0 = 768, T1 = T0 + 32, T2 = T1 + 256, T3 = T2 + 1024;
    {
        if (t < T0) { const int kt = t & 7, ntile = t >> 3; cvt_tile(a.in[3] + (size_t)l * DM * PIN, PIN, kt * 256, ntile * 64, (bf16_t*)(wb + WB_WIN), DM, ntile * 64, tl); }
        else if (t < T1) { const int u = t - T0, kt = u & 1, ntile = u >> 1; const int n0 = ntile * 64, pn = n0 >> 8, bj = (n0 >> 7) & 1, cc = n0 & 127;
            cvt_tile(a.in[21] + (size_t)l * 512 * 1024, 1024, kt * 256, 512 * bj + 128 * pn + cc, (bf16_t*)(wb + WB_GLU), 512, n0, tl); }
        else if (t < T2) { const int u = t - T1, kt = u & 7, ntile = u >> 3; cvt_tile(a.in[25] + (size_t)l * DM * DM, DM, kt * 256, ntile * 64, (bf16_t*)(wb + WB_WOUT), DM, ntile * 64, tl); }
        else if (t < T3) { const int u = t - T2, kt = u & 7, ntile = u >> 3; cvt_tile(a.in[26] + (size_t)l * DM * DFF, DFF, kt * 256, ntile * 64, (bf16_t*)(wb + WB_W1), DM, ntile * 64, tl); }
        else { const int u = t - T3, kt = u & 31, ntile = u >> 5; cvt_tile(a.in[27] + (size_t)l * DFF * DM, DM, kt * 256, ntile * 64, (bf16_t*)(wb + WB_W2), DFF, ntile * 64, tl); }
    }
}

__device__ void h2_phase(const Args& a, int l) {
    const int lane = launder_tid() & 63, wv = launder_tid() >> 6;
    const float* w1 = a.in[6] + (size_t)l * 33 * 64; const float* b1 = a.in[7] + l * 64; const float* fq = a.in[8] + l * 64;
    const float* w2 = a.in[9] + (size_t)l * 64 * 64; const float* b2 = a.in[10] + l * 64;
    float* H2T = (float*)(a.ws + WS_H2T);
    const float frj = fq[lane], b1j = b1[lane], b2j = b2[lane];
    for (int idx = launder_bid() * 8 + wv; idx < 20480; idx += gridDim.x * 8) {
        const int L = idx < 16384 ? 16384 : 4096, n = idx < 16384 ? idx : idx - 16384;
        const float t = (float)n / (float)(L - 1), w = 6.283185307179586f * (float)n / (float)L;
        float zv = 0.f;
        if (lane == 0) zv = t;
        else if (lane <= 32) { const int i = (lane - 1) & 15; const float f = 1e-4f + (float)i * ((15.0f - 1e-4f) / 15.0f); const float ar = f * w; zv = lane <= 16 ? cosf(ar) : -sinf(ar); }
        float pre = b1j;
        for (int k = 0; k < 33; ++k) pre += my_shfl(zv, k) * w1[k * 64 + lane];
        const float h1 = sinf(frj * pre);
        float pre2 = b2j;
        for (int k = 0; k < 64; ++k) pre2 += my_shfl(h1, k) * w2[k * 64 + lane];
        const float h2 = sinf(frj * pre2);
        float* dst = idx < 16384 ? H2T + (size_t)lane * 16384 + n : H2T + (size_t)64 * 16384 + (size_t)lane * 4096 + n;
        *dst = h2;
    }
}

template <int MODE>
__device__ void rows_phase(const Args& a, int l, unsigned char* lds) {
    const int tid = launder_tid(), lane = tid & 63, wv = tid >> 6;
    const bool do_gates = (MODE == 0) || (MODE == 2 && l + 1 < NLAYER);
    const bool do_h = (MODE != 2) || (l + 1 < NLAYER);
    const int ln = (MODE == 2) ? l + 1 : l;
    float* Wg = (float*)lds;
    if (do_gates) {
        const float* wsrc = a.in[3] + (size_t)ln * DM * PIN + NP;
        for (int it = tid; it < 2048 * 4; it += NT) { const int k = it >> 2, j4 = (it & 3) * 4; const float4 v = *(const float4*)(wsrc + (size_t)k * PIN + j4);
            Wg[(j4 + 0) * 2048 + k] = v.x; Wg[(j4 + 1) * 2048 + k] = v.y; Wg[(j4 + 2) * 2048 + k] = v.z; Wg[(j4 + 3) * 2048 + k] = v.w; }
        __syncthreads();
    }
    const float* gA = a.in[2] + (size_t)(l * 4 + (MODE == 1 ? 1 : 3)) * DM;
    const float* gH = a.in[2] + (size_t)(MODE == 1 ? l * 4 + 2 : ln * 4 + 0) * DM;
    const bf16_t* TMPp = (const bf16_t*)(a.ws + WS_TMP);
    bf16_t* H = (bf16_t*)(a.ws + WS_H); float* G = (float*)(a.ws + WS_G);
    const float* gb = a.in[23] + ln * 16;
    for (int row = launder_bid() * 8 + wv; row < TOK; row += gridDim.x * 8) {
        float4 x[8];
        float* xo = a.out + (size_t)row * DM;
        if (MODE == 0) { const float* xi = row < 16384 ? a.in[0] + (size_t)row * DM : a.in[1] + (size_t)(row - 16384) * DM;
#pragma unroll
            for (int i = 0; i < 8; ++i) { x[i] = *(const float4*)(xi + i * 256 + lane * 4); *(float4*)(xo + i * 256 + lane * 4) = x[i]; }
        } else {
            float4 tv[8]; float ss = 0.f; const bf16_t* tp = TMPp + (size_t)row * DM;
#pragma unroll
            for (int i = 0; i < 8; ++i) { const uint2 w = *(const uint2*)(tp + i * 256 + lane * 4); tv[i] = make_float4(bflo(w.x), bfhi(w.x), bflo(w.y), bfhi(w.y)); ss += tv[i].x * tv[i].x + tv[i].y * tv[i].y + tv[i].z * tv[i].z + tv[i].w * tv[i].w; }
            ss = wave_sum(ss); const float rs = rsqrtf(ss * (1.0f / DM) + EPSN);
#pragma unroll
            for (int i = 0; i < 8; ++i) { const float4 g = *(const float4*)(gA + i * 256 + lane * 4); float4 xv = *(const float4*)(xo + i * 256 + lane * 4);
                xv.x += tv[i].x * rs * g.x; xv.y += tv[i].y * rs * g.y; xv.z += tv[i].z * rs * g.z; xv.w += tv[i].w * rs * g.w; x[i] = xv; *(float4*)(xo + i * 256 + lane * 4) = xv; }
        }
        if (do_h) {
            float ss = 0.f;
#pragma unroll
            for (int i = 0; i < 8; ++i) ss += x[i].x * x[i].x + x[i].y * x[i].y + x[i].z * x[i].z + x[i].w * x[i].w;
            ss = wave_sum(ss); const float rs = rsqrtf(ss * (1.0f / DM) + EPSN);
            bf16_t* hp = H + (size_t)row * DM;
#pragma unroll
            for (int i = 0; i < 8; ++i) { const float4 g = *(const float4*)(gH + i * 256 + lane * 4);
                x[i].x *= rs * g.x; x[i].y *= rs * g.y; x[i].z *= rs * g.z; x[i].w *= rs * g.w;
                uint2 w; w.x = pk2(x[i].x, x[i].y); w.y = pk2(x[i].z, x[i].w); *(uint2*)(hp + i * 256 + lane * 4) = w; }
            if (do_gates) {
                float mine = 0.f;
#pragma unroll 1
                for (int j = 0; j < 16; ++j) { float p = 0.f;
#pragma unroll
                    for (int i = 0; i < 8; ++i) { const float4 wv4 = *(const float4*)(Wg + j * 2048 + i * 256 + lane * 4); p += x[i].x * wv4.x + x[i].y * wv4.y + x[i].z * wv4.z + x[i].w * wv4.w; }
                    p = wave_sum(p); if (lane == j) mine = p; }
                if (lane < 16) G[(size_t)row * 16 + lane] = mine + gb[lane];
            }
        }
    }
    __syncthreads();
}

template <int KIND>
__device__ __forceinline__ void conv_tile(const Args& a, int l, int tt0, int pc0, unsigned char* lds) {
    const int tid = launder_tid();
    const bf16_t* P = (const bf16_t*)(a.ws + WS_P);
    const float* cw = a.in[4] + (size_t)l * 3 * 3584; const float* cb = a.in[5] + (size_t)l * 3584;
    float* tin = (float*)lds;
    float* tout = tin + 66 * 257;
    const bool first = seq_first(tt0), last = seq_last(tt0 + 63);
    for (int it = tid; it < 66 * 32; it += NT) { const int r = it >> 5, sg = it & 31; const int t = tt0 - 1 + r;
        const bool valid = !((r == 0 && first) || (r == 65 && last));
        uint4 w = {0u, 0u, 0u, 0u}; if (valid) w = *(const uint4*)(P + (size_t)t * NP + pc0 + sg * 8);
        float* d = tin + r * 257 + sg * 8; d[0] = bflo(w.x); d[1] = bfhi(w.x); d[2] = bflo(w.y); d[3] = bfhi(w.y); d[4] = bflo(w.z); d[5] = bfhi(w.z); d[6] = bflo(w.w); d[7] = bfhi(w.w); }
    __syncthreads();
    { const int tt = tid & 63, cgp = tid >> 6;
#pragma unroll 4
      for (int e = 0; e < 32; ++e) { const int cc = cgp * 32 + e, c = pc0 + cc; float v;
          if (KIND == 2) v = tin[(tt + 1) * 257 + cc];
          else { v = cb[c] + cw[c] * tin[tt * 257 + cc] + cw[3584 + c] * tin[(tt + 1) * 257 + cc] + cw[2 * 3584 + c] * tin[(tt + 2) * 257 + cc];
              if (KIND == 1) v = v / (1.0f + __expf(-v)) * 0.0625f; }
          tout[cc * 65 + tt] = v; } }
    __syncthreads();
#pragma unroll
    for (int it = 0; it < 4; ++it) { const int cc = (tid >> 3) + 64 * it, ts = (tid & 7) * 8; const float* r = tout + cc * 65 + ts;
      if (KIND == 0) { float* d = (float*)(a.ws + WS_HYIN) + (size_t)(pc0 + cc) * TOK + tt0 + ts; *(float4*)d = make_float4(r[0], r[1], r[2], r[3]); *(float4*)(d + 4) = make_float4(r[4], r[5], r[6], r[7]); }
      else { bf16_t* d = (bf16_t*)(a.ws + (KIND == 1 ? WS_KT : WS_VT)) + (size_t)(pc0 - (KIND == 1 ? 2560 : 4096) + cc) * TOK + tt0 + ts;
          uint4 w; w.x = pk2(r[0], r[1]); w.y = pk2(r[2], r[3]); w.z = pk2(r[4], r[5]); w.w = pk2(r[6], r[7]); *(uint4*)d = w; } }
    if (KIND == 1) {
#pragma unroll
        for (int it = 0; it < 4; ++it) { const int item = it * NT + tid, tt = item >> 5, cs = (item & 31) * 8; const float* r = tout + cs * 65 + tt;
            uint4 w; w.x = pk2(r[0], r[65]); w.y = pk2(r[130], r[195]); w.z = pk2(r[260], r[325]); w.w = pk2(r[390], r[455]);
            *(uint4*)((bf16_t*)(a.ws + WS_QK) + (size_t)(tt0 + tt) * 2048 + (pc0 - 1536) + cs) = w; } }
    __syncthreads();
}
__device__ void conv_phase(const Args& a, int l, unsigned char* lds) {
    const int tid = launder_tid();
    const bf16_t* P = (const bf16_t*)(a.ws + WS_P);
    const float* cw = a.in[4] + (size_t)l * 3 * 3584; const float* cb = a.in[5] + (size_t)l * 3584;
    bf16_t* QK = (bf16_t*)(a.ws + WS_QK);
    for (int u = launder_bid(); u < 384 * 14; u += gridDim.x) {
        const int tt0 = (u / 14) * 64, ct = u % 14;
        if (ct < 6) conv_tile<0>(a, l, tt0, ct * 256, lds);
        else if (ct < 10) conv_tile<1>(a, l, tt0, 2560 + (ct - 6) * 256, lds);
        else conv_tile<2>(a, l, tt0, 4096 + (ct - 10) * 256, lds);
    }
    for (int u = launder_bid(); u < TOK / 32; u += gridDim.x) {
#pragma unroll 1
        for (int it = 0; it < 8; ++it) { const int item = it * NT + tid; const int t = u * 32 + (item >> 7), c8 = (item & 127) * 8; const int c = 1536 + c8;
            const uint4 w1 = *(const uint4*)(P + (size_t)t * NP + c);
            uint4 w0 = {0u, 0u, 0u, 0u}, w2 = {0u, 0u, 0u, 0u};
            if (!seq_first(t)) w0 = *(const uint4*)(P + (size_t)(t - 1) * NP + c);
            if (!seq_last(t)) w2 = *(const uint4*)(P + (size_t)(t + 1) * NP + c);
            const unsigned a0[4] = {w0.x, w0.y, w0.z, w0.w}, a1[4] = {w1.x, w1.y, w1.z, w1.w}, a2[4] = {w2.x, w2.y, w2.z, w2.w};
            float o[8];
#pragma unroll
            for (int e = 0; e < 8; ++e) { const int cc = c + e; const float p0 = (e & 1) ? bfhi(a0[e >> 1]) : bflo(a0[e >> 1]), p1 = (e & 1) ? bfhi(a1[e >> 1]) : bflo(a1[e >> 1]), p2 = (e & 1) ? bfhi(a2[e >> 1]) : bflo(a2[e >> 1]);
                float v = cb[cc] + cw[cc] * p0 + cw[3584 + cc] * p1 + cw[2 * 3584 + cc] * p2; o[e] = v / (1.0f + __expf(-v)); }
            uint4 w; w.x = pk2(o[0], o[1]); w.y = pk2(o[2], o[3]); w.z = pk2(o[4], o[5]); w.w = pk2(o[6], o[7]);
            *(uint4*)(QK + (size_t)t * 2048 + c8) = w; }
    }
}

__device__ void gate_local_phase(const Args& a) {
    const int tid = launder_tid(), lane = tid & 63, wv = tid >> 6;
    const float* G = (const float*)(a.ws + WS_G);
    float* BJ = (float*)(a.ws + WS_BJ); float* PMJ = (float*)(a.ws + WS_PMJ); float* LOC = (float*)(a.ws + WS_LOC); bf16_t* WL = (bf16_t*)(a.ws + WS_WL); float2* BLML = (float2*)(a.ws + WS_BLML);
    for (int wt = launder_bid() * 8 + wv; wt < 8 * 384; wt += gridDim.x * 8) {
        const int dh = wt / 384, gc = wt % 384, dir = dh >> 2, head = dh & 3;
        const int t = dir ? gc * 64 + 63 - lane : gc * 64 + lane;
        const float ig = G[(size_t)t * 16 + dir * 8 + head], fg = G[(size_t)t * 16 + dir * 8 + 4 + head];
        const float lf = fminf(fg, 0.f) - log1pf(__expf(-fabsf(fg)));
        float b = lf;
#pragma unroll
        for (int o = 1; o < 64; o <<= 1) { const float t2 = my_shfl_up(b, o, lane); if (lane >= o) b += t2; }
        float pm = ig - b;
#pragma unroll
        for (int o = 1; o < 64; o <<= 1) { const float t2 = my_shfl_up(pm, o, lane); if (lane >= o) pm = fmaxf(pm, t2); }
        const float blast = my_shfl(b, 63), ml = wave_max(blast - b + ig);
        const size_t o1 = (size_t)dh * TOK + t;
        BJ[o1] = b; PMJ[o1] = pm; LOC[o1] = ig - b; WL[o1] = f2bf(__expf((ig - b) - (ml - blast)));
        if (lane == 0) BLML[dh * 384 + gc] = make_float2(blast, ml);
    }
}
__device__ void sloc_phase(const Args& a) {
    const int tid = launder_tid(), lane = tid & 63, wv = tid >> 6, fr = lane & 15, fq = lane >> 4;
    const bf16_t* QK = (const bf16_t*)(a.ws + WS_QK); bf16_t* SL = (bf16_t*)(a.ws + WS_SL);
    const float* PMJ = (const float*)(a.ws + WS_PMJ); const float* LOC = (const float*)(a.ws + WS_LOC);
    for (int wt = launder_bid() * 8 + wv; wt < 8 * 384 * 4; wt += gridDim.x * 8) {
        const int rt = wt & 3, cg = wt >> 2, dh = cg / 384, gc = cg % 384, dir = dh >> 2, head = dh & 3, nb = gc * 64;
        const int jrow = rt * 16 + fr, tj = dir ? nb + 63 - jrow : nb + jrow;
        bf16x8 qf[8];
        { const bf16_t* qrow = QK + (size_t)tj * 2048 + head * 256 + fq * 8;
#pragma unroll
          for (int kk = 0; kk < 8; ++kk) qf[kk] = *(const bf16x8*)(qrow + kk * 32); }
        float pmr[4];
#pragma unroll
        for (int jj = 0; jj < 4; ++jj) { const int j = rt * 16 + fq * 4 + jj; pmr[jj] = PMJ[(size_t)dh * TOK + (dir ? nb + 63 - j : nb + j)]; }
#pragma unroll
        for (int ct = 0; ct < 4; ++ct) { f32x4 S = (f32x4){0.f, 0.f, 0.f, 0.f};
            const int sn = ct * 16 + fr; const bf16_t* krow = QK + (size_t)(nb + sn) * 2048 + 1024 + head * 256 + fq * 8;
#pragma unroll
            for (int kk = 0; kk < 8; ++kk) { const bf16x8 kf = *(const bf16x8*)(krow + kk * 32); S = __builtin_amdgcn_mfma_f32_16x16x32_bf16(qf[kk], kf, S, 0, 0, 0); }
            const float lc = LOC[(size_t)dh * TOK + nb + sn]; const int sd = dir ? 63 - sn : sn;
#pragma unroll
            for (int jj = 0; jj < 4; ++jj) { const int j = rt * 16 + fq * 4 + jj; const float v = (sd <= j) ? S[jj] * __expf(lc - pmr[jj]) : 0.f;
                SL[((size_t)dh * 384 + gc) * 4096 + j * 64 + sn] = f2bf(v); } }
    }
}

__device__ void hf_phase(const Args& a, int l, unsigned char* lds) {
    const int tid = launder_tid(), lane = tid & 63, wv = tid >> 6, fr = lane & 15, fq = lane >> 4;
    const float* w3 = a.in[11] + (size_t)l * 64 * 2048;
    const float* H2T = (const float*)(a.ws + WS_H2T);
    for (int u = launder_bid(); u < 40 * 32; u += gridDim.x) {
        const int nt = u / 32, col0 = (u % 32) * 64;
        const int L = nt < 32 ? 16384 : 4096, n0 = (nt < 32 ? nt : nt - 32) * 512 + wv * 64;
        const float* hsrc = nt < 32 ? H2T : H2T + (size_t)64 * 16384;
        const int o = col0 >> 10, dir = (col0 >> 9) & 1, cb0 = col0 & 511;
        bf16_t* hf = (bf16_t*)(a.ws + (o ? WS_HF1 : WS_HF0)) + (nt < 32 ? 0 : HF_G1);
        float bw[4][16];
#pragma unroll
        for (int ctile = 0; ctile < 4; ++ctile)
#pragma unroll
            for (int kk = 0; kk < 16; ++kk) bw[ctile][kk] = w3[(size_t)(4 * kk + fq) * 2048 + col0 + ctile * 16 + fr];
#pragma unroll 1
        for (int ntile = 0; ntile < 4; ++ntile) {
            const int nb = n0 + ntile * 16;
            float aw[16];
#pragma unroll
            for (int kk = 0; kk < 16; ++kk) aw[kk] = hsrc[(size_t)(4 * kk + fq) * L + nb + fr];
            float tn[4];
#pragma unroll
            for (int jj = 0; jj < 4; ++jj) tn[jj] = (float)(nb + fq * 4 + jj) / (float)(L - 1);
#pragma unroll
            for (int ctile = 0; ctile < 4; ++ctile) { f32x4 acc = (f32x4){0.f, 0.f, 0.f, 0.f};
#pragma unroll
                for (int kk = 0; kk < 16; ++kk) acc = __builtin_amdgcn_mfma_f32_16x16x4f32(aw[kk], bw[ctile][kk], acc, 0, 0, 0);
                const int c = cb0 + ctile * 16 + fr; const float dl = fabsf(-3.0701134573253943f + (float)c * ((-15.350567286626972f + 3.0701134573253943f) / 511.0f));
                uint2 w; w.x = pk2(acc[0] * __expf(-tn[0] * dl), acc[1] * __expf(-tn[1] * dl)); w.y = pk2(acc[2] * __expf(-tn[2] * dl), acc[3] * __expf(-tn[3] * dl));
                *(uint2*)(hf + (size_t)(dir * 512 + c) * L + nb + fq * 4) = w; }
        }
    }
}

constexpr int S5_SEG = 128;
struct S5Dir { float ar, ai, asr, asi; bf16x8 bm[8]; bf16x8 cm[4]; };
__device__ __forceinline__ void s5_coef(const Args& a, int l, int dir, int g, int p, float& ar, float& ai, float& cr, float& ci, float& asr, float& asi) {
    const size_t o1 = (((size_t)l * 2 + dir) * 32 + g) * 64 + p;
    const float lr = fminf(a.in[13][o1], -1e-4f), li = a.in[14][o1];
    const float dt = expf(a.in[15][((size_t)l * 2 + dir) * 32 + g]);
    const float mag = expf(lr * dt); float sn, cs; sincosf(li * dt, &sn, &cs);
    ar = mag * cs; ai = mag * sn;
    const float mags = expf(lr * dt * (float)S5_SEG); sincosf(li * dt * (float)S5_SEG, &sn, &cs); asr = mags * cs; asi = mags * sn;
    const float nr = ar - 1.0f, ni = ai, den = 1.0f / (lr * lr + li * li);
    cr = (nr * lr + ni * li) * den; ci = (ni * lr - nr * li) * den;
}
__device__ __forceinline__ void s5_setup(const Args& a, int l, int dir, int g, int lane, bool need_c, S5Dir& q) {
    const int fr = lane & 15, fq = lane >> 4;
    float cr, ci; s5_coef(a, l, dir, g, lane, q.ar, q.ai, cr, ci, q.asr, q.asi);
    typedef unsigned u32x4_ __attribute__((ext_vector_type(4)));
#pragma unroll
    for (int ct = 0; ct < 8; ++ct) { const int pp = ct * 8 + (fr >> 1), part = fr & 1;
        const float pcr = my_shfl(cr, pp), pci = my_shfl(ci, pp);
        u32x4_ w = {0u, 0u, 0u, 0u};
        if (fq < 2) { const size_t ob = ((((size_t)l * 2 + dir) * 32 + g) * 64 + pp) * 16 + fq * 8; const float4 r0 = *(const float4*)(a.in[16] + ob), r1 = *(const float4*)(a.in[16] + ob + 4), i0 = *(const float4*)(a.in[17] + ob), i1 = *(const float4*)(a.in[17] + ob + 4);
            const float re[8] = {r0.x, r0.y, r0.z, r0.w, r1.x, r1.y, r1.z, r1.w}, im[8] = {i0.x, i0.y, i0.z, i0.w, i1.x, i1.y, i1.z, i1.w}; float v[8];
#pragma unroll
            for (int e = 0; e < 8; ++e) v[e] = part ? (pcr * im[e] + pci * re[e]) : (pcr * re[e] - pci * im[e]);
            w.x = pk2(v[0], v[1]); w.y = pk2(v[2], v[3]); w.z = pk2(v[4], v[5]); w.w = pk2(v[6], v[7]); }
        q.bm[ct] = __builtin_bit_cast(bf16x8, w); }
    if (need_c) {
        const float* cre = a.in[18] + ((((size_t)l * 2 + dir) * 32 + g) * 16 + fr) * 64; const float* cim = a.in[19] + ((((size_t)l * 2 + dir) * 32 + g) * 16 + fr) * 64;
#pragma unroll
        for (int kk = 0; kk < 4; ++kk) { const int p0 = kk * 16 + fq * 4; const float4 r = *(const float4*)(cre + p0), i = *(const float4*)(cim + p0);
            u32x4_ w; w.x = pk2(r.x, -i.x); w.y = pk2(r.y, -i.y); w.z = pk2(r.z, -i.z); w.w = pk2(r.w, -i.w); q.cm[kk] = __builtin_bit_cast(bf16x8, w); }
    }
}
__device__ __forceinline__ void s5_bu(const S5Dir& q, const float* us, float* buf, int bb, int fr, int fq) {
    typedef unsigned u32x4_ __attribute__((ext_vector_type(4)));
    u32x4_ w = {0u, 0u, 0u, 0u};
    if (fq < 2) { const float* ur = us + (bb * 16 + fr) * 16 + fq * 8; const float4 u0 = *(const float4*)ur, u1 = *(const float4*)(ur + 4); w.x = pk2(u0.x, u0.y); w.y = pk2(u0.z, u0.w); w.z = pk2(u1.x, u1.y); w.w = pk2(u1.z, u1.w); }
    const bf16x8 af = __builtin_bit_cast(bf16x8, w);
#pragma unroll
    for (int ct = 0; ct < 8; ++ct) { f32x4 acc = (f32x4){0.f, 0.f, 0.f, 0.f}; acc = __builtin_amdgcn_mfma_f32_16x16x32_bf16(af, q.bm[ct], acc, 0, 0, 0);
#pragma unroll
        for (int jj = 0; jj < 4; ++jj) buf[(fq * 4 + jj) * 132 + ct * 16 + fr] = acc[jj]; }
}
__device__ __forceinline__ void s5_stage_u(const bf16_t* P, int t0, int g, float* us, int lane) {
#pragma unroll
    for (int it = 0; it < 4; ++it) { const int item = it * 64 + lane, tt = item >> 1, hh = (item & 1) * 8;
        const uint4 w = *(const uint4*)(P + (size_t)(t0 + tt) * NP + 3584 + g * 16 + hh);
        float* d = us + tt * 16 + hh; *(float4*)d = make_float4(bflo(w.x), bfhi(w.x), bflo(w.y), bfhi(w.y)); *(float4*)(d + 4) = make_float4(bflo(w.z), bfhi(w.z), bflo(w.w), bfhi(w.w)); }
}
__device__ void s5_l1_phase(const Args& a, int l, unsigned char* lds) {
    const int tid = launder_tid(), lane = tid & 63, wv = tid >> 6, fr = lane & 15, fq = lane >> 4;
    const bf16_t* P = (const bf16_t*)(a.ws + WS_P); float2* FIN = (float2*)(a.ws + WS_FIN);
    float* us = (float*)lds + wv * (S5_SEG * 16 + 16 * 132);
    float* buf = us + S5_SEG * 16;
    for (int bt = launder_bid(); bt < 768; bt += gridDim.x) {
        const int wt = bt * 8 + wv, sg = wt >> 5, g = wt & 31, t0 = sg * S5_SEG;
        __syncthreads();
        s5_stage_u(P, t0, g, us, lane);
        __syncthreads();
#pragma unroll 1
        for (int dir = 0; dir < 2; ++dir) {
            S5Dir q; s5_setup(a, l, dir, g, lane, false, q);
            float xr = 0.f, xi = 0.f;
#pragma unroll 1
            for (int b = 0; b < 8; ++b) { const int bb = dir ? 7 - b : b;
                s5_bu(q, us, buf, bb, fr, fq);
                __syncthreads();
#pragma unroll
                for (int s = 0; s < 16; ++s) { const int s16 = dir ? 15 - s : s; const float2 bu = *(const float2*)(buf + s16 * 132 + 2 * lane);
                    const float nr = q.ar * xr - q.ai * xi + bu.x, ni = q.ar * xi + q.ai * xr + bu.y; xr = nr; xi = ni; }
                __syncthreads();
            }
            FIN[(((size_t)sg * 2 + dir) * 32 + g) * 64 + lane] = make_float2(xr, xi);
        }
    }
    __syncthreads();
}
template <int DIR>
__device__ __forceinline__ void s5_l3_dir(const Args& a, int l, int sg, int g, int sfirst, int slast, const float* us, float* buf, f32x4 (&acc)[8], int lane, int fr, int fq) {
    const float2* FIN = (const float2*)(a.ws + WS_FIN);
    S5Dir q; s5_setup(a, l, DIR, g, lane, false, q);
    float cmf[32];
    { const float* cre = a.in[18] + ((((size_t)l * 2 + DIR) * 32 + g) * 16 + fr) * 64 + fq * 16; const float* cim = a.in[19] + ((((size_t)l * 2 + DIR) * 32 + g) * 16 + fr) * 64 + fq * 16;
#pragma unroll
      for (int pp = 0; pp < 16; ++pp) { cmf[2 * pp] = cre[pp]; cmf[2 * pp + 1] = -cim[pp]; } }
    float xr = 0.f, xi = 0.f;
    if (DIR == 0) { for (int j = sfirst; j < sg; ++j) { const float2 f = FIN[(((size_t)j * 2 + 0) * 32 + g) * 64 + lane]; const float nr = q.asr * xr - q.asi * xi + f.x, ni = q.asr * xi + q.asi * xr + f.y; xr = nr; xi = ni; } }
    else { for (int j = slast; j > sg; --j) { const float2 f = FIN[(((size_t)j * 2 + 1) * 32 + g) * 64 + lane]; const float nr = q.asr * xr - q.asi * xi + f.x, ni = q.asr * xi + q.asi * xr + f.y; xr = nr; xi = ni; } }
#pragma unroll
    for (int b = 0; b < 8; ++b) {
        const int bb = DIR ? 7 - b : b;
        s5_bu(q, us, buf, bb, fr, fq);
        __syncthreads();
#pragma unroll
        for (int s = 0; s < 16; ++s) { const int s16 = DIR ? 15 - s : s; float2* slot = (float2*)(buf + s16 * 132 + 2 * lane); const float2 bu = *slot;
            const float nr = q.ar * xr - q.ai * xi + bu.x, ni = q.ar * xi + q.ai * xr + bu.y; xr = nr; xi = ni; *slot = make_float2(xr, xi); }
        __syncthreads();
        { const float* xrow = buf + fr * 132 + fq * 32; f32x4 c = acc[bb];
#pragma unroll
          for (int k4 = 0; k4 < 8; ++k4) { const float4 xv = *(const float4*)(xrow + k4 * 4);
              c = __builtin_amdgcn_mfma_f32_16x16x4f32(xv.x, cmf[k4 * 4 + 0], c, 0, 0, 0); c = __builtin_amdgcn_mfma_f32_16x16x4f32(xv.y, cmf[k4 * 4 + 1], c, 0, 0, 0);
              c = __builtin_amdgcn_mfma_f32_16x16x4f32(xv.z, cmf[k4 * 4 + 2], c, 0, 0, 0); c = __builtin_amdgcn_mfma_f32_16x16x4f32(xv.w, cmf[k4 * 4 + 3], c, 0, 0, 0); }
          acc[bb] = c; }
        __syncthreads();
    }
}
__device__ void s5_l3_task(const Args& a, int l, int bt, unsigned char* lds) {
    const int tid = launder_tid(), lane = tid & 63, wv = tid >> 6, fr = lane & 15, fq = lane >> 4;
    const bf16_t* P = (const bf16_t*)(a.ws + WS_P); bf16_t* Y = (bf16_t*)(a.ws + WS_S5Y);
    float* us = (float*)lds + wv * (S5_SEG * 16 + 16 * 132);
    float* buf = us + S5_SEG * 16;
    const int wt = bt * 8 + wv, sg = wt >> 5, g = wt & 31, t0 = sg * S5_SEG;
    const int sfirst = sg < 128 ? 0 : (sg < 160 ? 128 : 160), slast = sg < 128 ? 127 : (sg < 160 ? 159 : 191);
    __syncthreads();
    s5_stage_u(P, t0, g, us, lane);
    __syncthreads();
    f32x4 acc[8];
#pragma unroll
    for (int b = 0; b < 8; ++b) acc[b] = (f32x4){0.f, 0.f, 0.f, 0.f};
    s5_l3_dir<0>(a, l, sg, g, sfirst, slast, us, buf, acc, lane, fr, fq);
    s5_l3_dir<1>(a, l, sg, g, sfirst, slast, us, buf, acc, lane, fr, fq);
    const float dv = a.in[20][l * 512 + g * 16 + fr];
#pragma unroll
    for (int b = 0; b < 8; ++b)
#pragma unroll
        for (int j = 0; j < 4; ++j) { const int tt = b * 16 + fq * 4 + j; const float y = acc[b][j] + dv * us[tt * 16 + fr];
            const float inner = 0.7978845608028654f * (y + 0.044715f * y * y * y); const float gl = 0.5f * y * (1.0f + tanhf(inner));
            Y[(size_t)(t0 + tt) * 512 + g * 16 + fr] = f2bf(gl); }
}

typedef float f32x2 __attribute__((ext_vector_type(2)));
__device__ __forceinline__ f32x2 rot_mi(f32x2 v) { return (f32x2){v.y, -v.x}; }
__device__ __forceinline__ f32x2 rot_pi(f32x2 v) { return (f32x2){-v.y, v.x}; }
__device__ __forceinline__ f32x2 mul_w(f32x2 d, float c, float s) { return d * c + rot_mi(d) * s; }
__device__ __forceinline__ f32x2 mul_wc(f32x2 d, float c, float s) { return d * c + rot_pi(d) * s; }
template <int L> __device__ __forceinline__ void fft_dif(float2* Xf) {
    const int tid = launder_tid(); f32x2* X = (f32x2*)Xf;
#pragma unroll 1
    for (int q = L / 4; q >= 1; q >>= 2) {
        const float inv4 = 1.0f / (float)(4 * q);
#pragma unroll 2
        for (int i = tid; i < L / 4; i += NT) { const int k = i & (q - 1), j = ((i - k) << 2) + k;
            f32x2 x0, x1, x2, x3;
            if (q == 1) { const f32x4 lo = *(const f32x4*)(X + j), hi = *(const f32x4*)(X + j + 2); x0 = (f32x2){lo.x, lo.y}; x1 = (f32x2){lo.z, lo.w}; x2 = (f32x2){hi.x, hi.y}; x3 = (f32x2){hi.z, hi.w}; }
            else { x0 = X[j]; x1 = X[j + q]; x2 = X[j + 2 * q]; x3 = X[j + 3 * q]; }
            const float f4 = (float)k * inv4; const float c4 = cosr(f4), s4 = sinr(f4), c2 = cosr(2.0f * f4), s2 = sinr(2.0f * f4);
            const f32x2 y0 = x0 + x2, y1 = x1 + x3;
            const f32x2 y2 = mul_w(x0 - x2, c4, s4);
            const f32x2 y3 = rot_mi(mul_w(x1 - x3, c4, s4));
            const f32x2 z0 = y0 + y1, z2 = y2 + y3;
            const f32x2 z1 = mul_w(y0 - y1, c2, s2), z3 = mul_w(y2 - y3, c2, s2);
            if (q == 1) { *(f32x4*)(X + j) = (f32x4){z0.x, z0.y, z1.x, z1.y}; *(f32x4*)(X + j + 2) = (f32x4){z2.x, z2.y, z3.x, z3.y}; }
            else { X[j] = z0; X[j + q] = z1; X[j + 2 * q] = z2; X[j + 3 * q] = z3; } }
        __syncthreads();
    }
}
template <int L> __device__ __forceinline__ void fft_dit_inv(float2* Xf) {
    const int tid = launder_tid(); f32x2* X = (f32x2*)Xf;
#pragma unroll 1
    for (int q = 1; q <= L / 4; q <<= 2) {
        const float inv4 = 1.0f / (float)(4 * q);
#pragma unroll 2
        for (int i = tid; i < L / 4; i += NT) { const int k = i & (q - 1), j = ((i - k) << 2) + k;
            f32x2 z0, z1, z2, z3;
            if (q == 1) { const f32x4 lo = *(const f32x4*)(X + j), hi = *(const f32x4*)(X + j + 2); z0 = (f32x2){lo.x, lo.y}; z1 = (f32x2){lo.z, lo.w}; z2 = (f32x2){hi.x, hi.y}; z3 = (f32x2){hi.z, hi.w}; }
            else { z0 = X[j]; z1 = X[j + q]; z2 = X[j + 2 * q]; z3 = X[j + 3 * q]; }
            const float f4 = (float)k * inv4; const float c4 = cosr(f4), s4 = sinr(f4), c2 = cosr(2.0f * f4), s2 = sinr(2.0f * f4);
            const f32x2 b0 = mul_wc(z1, c2, s2), b1 = mul_wc(z3, c2, s2);
            const f32x2 y0 = z0 + b0, y1 = z0 - b0, y2 = z2 + b1, y3 = z2 - b1;
            const f32x2 g0 = mul_wc(y2, c4, s4);
            const f32x2 g1 = rot_pi(mul_wc(y3, c4, s4));
            const f32x2 x0 = y0 + g0, x2 = y0 - g0, x1 = y1 + g1, x3 = y1 - g1;
            if (q == 1) { *(f32x4*)(X + j) = (f32x4){x0.x, x0.y, x1.x, x1.y}; *(f32x4*)(X + j + 2) = (f32x4){x2.x, x2.y, x3.x, x3.y}; }
            else { X[j] = x0; X[j + q] = x1; X[j + 2 * q] = x2; X[j + 3 * q] = x3; } }
        __syncthreads();
    }
}
__device__ __forceinline__ f32x2 cmul(f32x2 a, f32x2 b) { return (f32x2){a.x * b.x - a.y * b.y, a.x * b.y + a.y * b.x}; }
__device__ __forceinline__ f32x2 cconj(f32x2 a) { return (f32x2){a.x, -a.y}; }
template <int L, int NSEQ>
__device__ void hyena_task(const Args& a, int l, int c, unsigned char* lds) {
    constexpr int HP = L / 2 / NT;
    constexpr int LOGN = (L == 16384) ? 14 : 12;
    const int tid = launder_tid();
    f32x2* X = (f32x2*)lds;
    float* red = (float*)(lds + 131072);
    f32x2* SCR = (f32x2*)(a.ws + WS_SCR) + (size_t)launder_bid() * 16384;
    float* HYIN = (float*)(a.ws + WS_HYIN);
    const int tok0 = (L == 16384) ? 0 : 16384;
    f32x2 y[NSEQ][HP];
    float* zrow = HYIN + (size_t)c * TOK + tok0;
    __syncthreads();
#pragma unroll 1
    for (int o = 0; o < 2; ++o) {
        const bf16_t* hfw = (const bf16_t*)(a.ws + (o ? WS_HF1 : WS_HF0)) + (L == 16384 ? 0 : HF_G1) + (size_t)c * L;
        const bf16_t* hbw = (const bf16_t*)(a.ws + (o ? WS_HF1 : WS_HF0)) + (L == 16384 ? 0 : HF_G1) + (size_t)(512 + c) * L;
        float ssq = 0.f;
#pragma unroll 4
        for (int e = 0; e < 2 * HP; ++e) { const int n = tid + NT * e; const float Av = bf2f(hfw[n]); const float Bw = n >= 1 ? bf2f(hbw[n]) : 0.f; ssq += Av * Av + Bw * Bw; }
        ssq = wave_sum(ssq);
        if ((tid & 63) == 0) red[tid >> 6] = ssq;
        __syncthreads();
        float tot = 0.f;
#pragma unroll
        for (int w = 0; w < 8; ++w) tot += red[w];
        const float nrm = rsqrtf(tot + EPSN) * (1.0f / (float)L);
#pragma unroll 4
        for (int e = 0; e < 2 * HP; ++e) { const int n = tid + NT * e; f32x2 v;
            if (n < L / 2) { const unsigned w = *(const unsigned*)(hfw + 2 * n); v = (f32x2){bflo(w), bfhi(w)}; }
            else { const int m = 2 * n; v = (f32x2){m == L ? 0.f : bf2f(hbw[2 * L - m]), bf2f(hbw[2 * L - m - 1])}; }
            X[n] = v; }
        __syncthreads();
        fft_dif<L>((float2*)X);
#pragma unroll 4
        for (int e = 0; e < HP; ++e) { const int k = tid + NT * e;
            if (k == 0) { const f32x2 z0 = X[0]; SCR[0] = (f32x2){z0.x + z0.y, z0.x - z0.y}; }
            else { const int j = (int)(__brev((unsigned)k) >> (32 - LOGN)), jn = (int)(__brev((unsigned)(L - k)) >> (32 - LOGN));
                const f32x2 A = X[j], B = cconj(X[jn]); const f32x2 E = (A + B) * 0.5f, D = A - B; const f32x2 O = (f32x2){0.5f * D.y, -0.5f * D.x};
                const float fr = (float)k * (1.0f / (float)(2 * L)); const f32x2 wO = mul_w(O, cosr(fr), sinr(fr));
                SCR[k] = E + wO; SCR[L - k] = cconj(E - wO); } }
        if (tid == 0) SCR[L / 2] = cconj(X[1]);
#pragma unroll
        for (int s = 0; s < NSEQ; ++s) {
            __syncthreads();
#pragma unroll 4
            for (int e = 0; e < 2 * HP; ++e) { const int n = tid + NT * e; f32x2 v = (f32x2){0.f, 0.f}; if (n < L / 2) v = *(const f32x2*)(zrow + s * L + 2 * n); X[n] = v; }
            __syncthreads();
            fft_dif<L>((float2*)X);
#pragma unroll 4
            for (int e = 0; e < HP; ++e) { const int k = tid + NT * e;
                if (k == 0) { const f32x2 z0 = X[0], k0 = SCR[0]; const float y0 = (z0.x + z0.y) * k0.x, yn = (z0.x - z0.y) * k0.y; X[0] = (f32x2){0.5f * (y0 + yn), 0.5f * (y0 - yn)}; }
                else { const int j = (int)(__brev((unsigned)k) >> (32 - LOGN)), jn = (int)(__brev((unsigned)(L - k)) >> (32 - LOGN));
                    const f32x2 A = X[j], B = cconj(X[jn]); const f32x2 E = (A + B) * 0.5f, D = A - B; const f32x2 O = (f32x2){0.5f * D.y, -0.5f * D.x};
                    const float fr = (float)k * (1.0f / (float)(2 * L)); const float cw = cosr(fr), sw = sinr(fr); const f32x2 wO = mul_w(O, cw, sw);
                    const f32x2 Yk = cmul(E + wO, SCR[k]), Yn = cconj(cmul(cconj(E - wO), SCR[L - k]));
                    const f32x2 Ep = (Yk + Yn) * 0.5f, Op = mul_wc((Yk - Yn) * 0.5f, cw, sw);
                    X[j] = Ep + rot_pi(Op); X[jn] = cconj(Ep) + rot_pi(cconj(Op)); } }
            if (tid == 0) { const f32x2 A = X[1]; X[1] = cconj(cmul(cconj(A), SCR[L / 2])); }
            __syncthreads();
            fft_dit_inv<L>((float2*)X);
#pragma unroll
            for (int e = 0; e < HP; ++e) y[s][e] = X[tid + NT * e];
        }
        __syncthreads();
        const float sk = a.in[12][((size_t)l * 2 + o) * 512 + c];
#pragma unroll
        for (int s = 0; s < NSEQ; ++s)
#pragma unroll
            for (int e = 0; e < HP; ++e) { const int n = tid + NT * e; const f32x2 gt = *(const f32x2*)(HYIN + (size_t)((o + 1) * 512 + c) * TOK + tok0 + s * L + 2 * n); const f32x2 zo = *(const f32x2*)(zrow + s * L + 2 * n);
                *(f32x2*)(zrow + s * L + 2 * n) = gt * (y[s][e] * nrm + zo * sk); if ((e & 3) == 3) asm volatile("" ::: "memory"); }
    }
}

__device__ __forceinline__ bf16x8 scale_bf16x8(bf16x8 v, const float (&w)[8]) {
    typedef unsigned u32x4_ __attribute__((ext_vector_type(4)));
    const u32x4_ u = __builtin_bit_cast(u32x4_, v); u32x4_ r;
    r.x = pk2(bflo(u.x) * w[0], bfhi(u.x) * w[1]); r.y = pk2(bflo(u.y) * w[2], bfhi(u.y) * w[3]); r.z = pk2(bflo(u.z) * w[4], bfhi(u.z) * w[5]); r.w = pk2(bflo(u.w) * w[6], bfhi(u.w) * w[7]);
    return __builtin_bit_cast(bf16x8, r);
}
constexpr int ML_NVT = 4, ML_VB = ML_NVT * 16, ML_ROWS = (ML_NVT + 1) * 16, ML_NVS = 256 / ML_VB;
struct MlCtx { const bf16_t* QK; const bf16_t* SL; const bf16_t* KT; const bf16_t* VT; const float* BJ; const float* PMJ; const bf16_t* WL; const float2* BLML; bf16_t* MLH; bf16_t* CTb0; bf16_t* VST;
               int dir, tok0, L, head, vs, dh, lane, fr, fq, rw; };
struct MlOutSet { bf16x8 qf[8], sf[2], vf[ML_NVT][2]; float pmv, bjv; float2 bm; };
struct MlUpdSet { bf16x8 kf[4][2], lc[2]; float2 bm; };
__device__ __forceinline__ int ml_nb(const MlCtx& x, int cc) { return x.dir ? x.tok0 + x.L - 64 * (cc + 1) : x.tok0 + 64 * cc; }
__device__ __forceinline__ void ml_load_out(const MlCtx& x, MlOutSet& s, int cc) {
    const int nb = ml_nb(x, cc), gc = nb >> 6, jrow = x.rw * 16 + x.fr, tj = x.dir ? nb + 63 - jrow : nb + jrow; const bf16_t* qrow = x.QK + (tj * 2048 + x.head * 256 + x.fq * 8);
#pragma unroll
    for (int kk = 0; kk < 8; ++kk) s.qf[kk] = *(const bf16x8*)(qrow + kk * 32);
    const bf16_t* srow = x.SL + ((x.dh * 384 + gc) * 4096 + jrow * 64 + x.fq * 8); s.sf[0] = *(const bf16x8*)(srow); s.sf[1] = *(const bf16x8*)(srow + 32);
#pragma unroll
    for (int vt = 0; vt < ML_NVT; ++vt) { const bf16_t* vrow = x.VT + ((vt * 16 + x.fr) * TOK + nb + x.fq * 8); s.vf[vt][0] = *(const bf16x8*)(vrow); s.vf[vt][1] = *(const bf16x8*)(vrow + 32); }
    s.pmv = x.PMJ[tj]; s.bjv = x.BJ[tj];
    s.bm = x.BLML[gc];
}
__device__ __forceinline__ void ml_load_upd(const MlCtx& x, MlUpdSet& s, int cc) {
    const int nb = ml_nb(x, cc);
#pragma unroll
    for (int di = 0; di < 4; ++di) { const bf16_t* krow = x.KT + (((x.rw * 4 + di) * 16 + x.fr) * TOK + nb + x.fq * 8); s.kf[di][0] = *(const bf16x8*)(krow); s.kf[di][1] = *(const bf16x8*)(krow + 32); }
#pragma unroll
    for (int kk = 0; kk < 2; ++kk) s.lc[kk] = *(const bf16x8*)(x.WL + nb + kk * 32 + x.fq * 8);
    s.bm = x.BLML[nb >> 6];
}
#define ML_BAR() do { asm volatile("s_waitcnt lgkmcnt(0)" ::: "memory"); __builtin_amdgcn_s_barrier(); asm volatile("" ::: "memory"); } while (0)
__device__ __forceinline__ void ml_publish_v(const MlCtx& x, const MlOutSet& s, int cc) {
    bf16_t* dst = x.VST + (cc & 1) * (ML_NVT * 1024) + x.lane * 8;
#pragma unroll
    for (int vt = 0; vt < ML_NVT; ++vt) { *(bf16x8*)(dst + vt * 1024) = s.vf[vt][0]; *(bf16x8*)(dst + vt * 1024 + 512) = s.vf[vt][1]; }
}
__device__ __forceinline__ void ml_out_step(const MlCtx& x, MlOutSet& s, const MlOutSet& sn, int c, int nchunk, float& m) {
    const int nb = ml_nb(x, c);
    const bf16_t* CTb = x.CTb0 + (c & 1) * (ML_ROWS * 264);
    const int jrow = x.rw * 16 + x.fr, tj = x.dir ? nb + 63 - jrow : nb + jrow;
    const float mx = fmaxf(m, s.pmv); float inter = __expf(m - mx), rsc = __expf(s.pmv - mx); const float emt = __expf(-s.bjv - mx);
    const float mnew = fmaxf(s.bm.x + m, s.bm.y);
    bf16x8 bA[8];
    { const bf16_t* crow = CTb + (ML_NVT * 16 + x.fr) * 264 + x.fq * 8;
#pragma unroll
      for (int kk = 0; kk < 8; ++kk) bA[kk] = *(const bf16x8*)(crow + kk * 32);
      f32x4 Oc = (f32x4){0.f, 0.f, 0.f, 0.f}, Os = (f32x4){0.f, 0.f, 0.f, 0.f};
#pragma unroll
      for (int kk = 0; kk < 8; ++kk) Oc = __builtin_amdgcn_mfma_f32_16x16x32_bf16(bA[kk], s.qf[kk], Oc, 0, 0, 0);
      const short one = (x.fr == 0) ? (short)0x3F80 : (short)0; const bf16x8 ones = {one, one, one, one, one, one, one, one};
#pragma unroll
      for (int kk = 0; kk < 2; ++kk) Os = __builtin_amdgcn_mfma_f32_16x16x32_bf16(ones, s.sf[kk], Os, 0, 0, 0);
      float den = inter * Oc[0] + rsc * Os[0]; den = my_shfl(den, x.lane & 15);
      const float dnv = 1.0f / fmaxf(fabsf(den), emt); inter *= dnv; rsc *= dnv; }
#pragma unroll
    for (int ct = 0; ct < ML_NVT; ++ct) {
        __builtin_amdgcn_sched_barrier(0);
        { const bf16_t* crow = CTb + (ct * 16 + x.fr) * 264 + x.fq * 8;
#pragma unroll
          for (int kk = 0; kk < 8; ++kk) bA[kk] = *(const bf16x8*)(crow + kk * 32); }
        __builtin_amdgcn_sched_barrier(0);
        f32x4 Oc = (f32x4){0.f, 0.f, 0.f, 0.f}, Os = (f32x4){0.f, 0.f, 0.f, 0.f};
#pragma unroll
        for (int kk = 0; kk < 8; ++kk) Oc = __builtin_amdgcn_mfma_f32_16x16x32_bf16(bA[kk], s.qf[kk], Oc, 0, 0, 0);
#pragma unroll
        for (int kk = 0; kk < 2; ++kk) Os = __builtin_amdgcn_mfma_f32_16x16x32_bf16(s.vf[ct][kk], s.sf[kk], Os, 0, 0, 0);
        uint2 w_; w_.x = pk2(inter * Oc[0] + rsc * Os[0], inter * Oc[1] + rsc * Os[1]); w_.y = pk2(inter * Oc[2] + rsc * Os[2], inter * Oc[3] + rsc * Os[3]);
        *(uint2*)(x.MLH + (tj * 1024 + x.head * 256 + x.vs * ML_VB + ct * 16 + x.fq * 4)) = w_; }
    __builtin_amdgcn_sched_barrier(0);
    if (c + 2 < nchunk) ml_load_out(x, s, c + 2);
    __builtin_amdgcn_sched_barrier(0);
    m = mnew;
    if (c + 1 < nchunk) ml_publish_v(x, sn, c + 1);
    ML_BAR();
}
__device__ __forceinline__ void ml_upd_step(const MlCtx& x, MlUpdSet& s, f32x4 (&CT)[ML_NVT + 1][4], int c, int nchunk, float& m) {
    bf16_t* CTn = x.CTb0 + ((c + 1) & 1) * (ML_ROWS * 264);
    const float mnew = fmaxf(s.bm.x + m, s.bm.y), decay = __expf(s.bm.x + m - mnew), wsc = __expf(s.bm.y - mnew);
    bf16x8 an[2], vf[ML_NVT][2];
    { const bf16_t* src = x.VST + (c & 1) * (ML_NVT * 1024) + x.lane * 8;
#pragma unroll
      for (int vt = 0; vt < ML_NVT; ++vt) { vf[vt][0] = *(const bf16x8*)(src + vt * 1024); vf[vt][1] = *(const bf16x8*)(src + vt * 1024 + 512); } }
#pragma unroll
    for (int kk = 0; kk < 2; ++kk) { typedef unsigned u32x4_ __attribute__((ext_vector_type(4))); const u32x4_ lw = __builtin_bit_cast(u32x4_, s.lc[kk]);
        const float w8[8] = {bflo(lw.x) * wsc, bfhi(lw.x) * wsc, bflo(lw.y) * wsc, bfhi(lw.y) * wsc, bflo(lw.z) * wsc, bfhi(lw.z) * wsc, bflo(lw.w) * wsc, bfhi(lw.w) * wsc};
#pragma unroll
        for (int di = 0; di < 4; ++di) s.kf[di][kk] = scale_bf16x8(s.kf[di][kk], w8);
        const short one = (x.fr == 0) ? (short)0x3F80 : (short)0; an[kk] = (bf16x8){one, one, one, one, one, one, one, one}; }
#pragma unroll
    for (int vt = 0; vt < ML_NVT + 1; ++vt)
#pragma unroll
        for (int di = 0; di < 4; ++di) { f32x4 cacc = CT[vt][di] * decay;
            cacc = __builtin_amdgcn_mfma_f32_16x16x32_bf16(s.kf[di][0], vt < ML_NVT ? vf[vt < ML_NVT ? vt : 0][0] : an[0], cacc, 0, 0, 0); cacc = __builtin_amdgcn_mfma_f32_16x16x32_bf16(s.kf[di][1], vt < ML_NVT ? vf[vt < ML_NVT ? vt : 0][1] : an[1], cacc, 0, 0, 0);
            CT[vt][di] = cacc; }
    __builtin_amdgcn_sched_barrier(0);
    if (c + 2 < nchunk) ml_load_upd(x, s, c + 2);
    __builtin_amdgcn_sched_barrier(0);
#pragma unroll
    for (int vt = 0; vt < ML_NVT + 1; ++vt)
#pragma unroll
        for (int di = 0; di < 4; ++di)
            { uint2 w_; w_.x = pk2(CT[vt][di][0], CT[vt][di][1]); w_.y = pk2(CT[vt][di][2], CT[vt][di][3]); *(uint2*)(CTn + (vt * 16 + x.fr) * 264 + (x.rw * 4 + di) * 16 + x.fq * 4) = w_; }
    m = mnew;
    ML_BAR();
}
__device__ void mlstm_task(const Args& a, int task, unsigned char* lds) {
    const int tid = launder_tid(), lane = tid & 63, wv = tid >> 6;
    int seq, rem; if (task < 8 * ML_NVS) { seq = 0; rem = task; } else { seq = 1 + (task - 8 * ML_NVS) / (8 * ML_NVS); rem = (task - 8 * ML_NVS) % (8 * ML_NVS); }
    MlCtx x;
    x.vs = rem % ML_NVS; x.dir = (rem / ML_NVS) & 1; x.head = rem / (2 * ML_NVS); x.dh = x.dir * 4 + x.head; x.lane = lane; x.fr = lane & 15; x.fq = lane >> 4; x.rw = wv & 3;
    x.L = seq == 0 ? 16384 : 4096; x.tok0 = seq == 0 ? 0 : 16384 + (seq - 1) * 4096; const int nchunk = x.L / 64;
    x.QK = (const bf16_t*)(a.ws + WS_QK); x.SL = (const bf16_t*)(a.ws + WS_SL);
    x.KT = (const bf16_t*)(a.ws + WS_KT) + (size_t)x.head * 256 * TOK; x.VT = (const bf16_t*)(a.ws + WS_VT) + (size_t)(x.head * 256 + x.vs * ML_VB) * TOK;
    x.BJ = (const float*)(a.ws + WS_BJ) + (size_t)x.dh * TOK; x.PMJ = (const float*)(a.ws + WS_PMJ) + (size_t)x.dh * TOK; x.WL = (const bf16_t*)(a.ws + WS_WL) + (size_t)x.dh * TOK;
    x.BLML = (const float2*)(a.ws + WS_BLML) + x.dh * 384;
    x.MLH = (bf16_t*)(a.ws + WS_MLH) + (size_t)x.dir * TOK * 1024;
    x.VST = (bf16_t*)(lds + 2 * ML_ROWS * 264 * 2);
    x.CTb0 = (bf16_t*)lds;
    __syncthreads();
    for (int i = tid; i < ML_ROWS * 264; i += NT) x.CTb0[i] = 0;
    __syncthreads();
    float m = 0.f;
    if (wv < 4) {
        MlOutSet s0, s1;
        ml_load_out(x, s0, 0); ml_load_out(x, s1, 1);
        ml_publish_v(x, s0, 0); ML_BAR();
#pragma unroll 1
        for (int c = 0; c < nchunk; c += 4) { ml_out_step(x, s0, s1, c, nchunk, m); ml_out_step(x, s1, s0, c + 1, nchunk, m); ml_out_step(x, s0, s1, c + 2, nchunk, m); ml_out_step(x, s1, s0, c + 3, nchunk, m); }
    } else {
        f32x4 CT[ML_NVT + 1][4];
#pragma unroll
        for (int i = 0; i < ML_NVT + 1; ++i)
#pragma unroll
            for (int j = 0; j < 4; ++j) CT[i][j] = (f32x4){0.f, 0.f, 0.f, 0.f};
        MlUpdSet s0, s1;
        ml_load_upd(x, s0, 0); ml_load_upd(x, s1, 1);
        ML_BAR();
#pragma unroll 1
        for (int c = 0; c < nchunk; c += 4) { ml_upd_step(x, s0, CT, c, nchunk, m); ml_upd_step(x, s1, CT, c + 1, nchunk, m); ml_upd_step(x, s0, CT, c + 2, nchunk, m); ml_upd_step(x, s1, CT, c + 3, nchunk, m); }
    }
    __syncthreads();
}
#undef ML_BAR

__device__ void groupnorm_phase(const Args& a, int l, unsigned char* lds) {
    const int tid = launder_tid(), tt = tid >> 4, sub = tid & 15;
    const float* gn = a.in[24] + (size_t)l * 2048;
    const float* HYIN = (const float*)(a.ws + WS_HYIN); const float* S5O = (const float*)(a.ws + WS_S5O); const bf16_t* MLH = (const bf16_t*)(a.ws + WS_MLH);
    const bf16_t* P = (const bf16_t*)(a.ws + WS_P); bf16_t* MIX = (bf16_t*)(a.ws + WS_MIX);
    float* hy = (float*)lds;
    for (int u = launder_bid(); u < TOK / 32; u += gridDim.x) {
        const int t0 = u * 32, t = t0 + tt;
        __syncthreads();
#pragma unroll
        for (int it = 0; it < 8; ++it) { const int c = (tid >> 3) + 64 * it, sg = (tid & 7) * 4; const float4 v = *(const float4*)(HYIN + (size_t)c * TOK + t0 + sg);
            float* d = hy + c * 33 + sg; d[0] = v.x; d[1] = v.y; d[2] = v.z; d[3] = v.w; }
        __syncthreads();
        { float ss = 0.f;
#pragma unroll
          for (int i = 0; i < 32; ++i) { const float v = hy[(sub + 16 * i) * 33 + tt]; ss += v * v; }
          ss += shflx(ss, 1, tid & 63); ss += shflx(ss, 2, tid & 63); ss += shflx(ss, 4, tid & 63); ss += shflx(ss, 8, tid & 63);
          const float rs = rsqrtf(ss * (1.0f / 512.0f) + EPSN);
#pragma unroll
          for (int i = 0; i < 4; ++i) { const int c0 = sub * 8 + 128 * i; float o[8];
#pragma unroll
              for (int e = 0; e < 8; ++e) o[e] = hy[(c0 + e) * 33 + tt] * rs * gn[c0 + e];
              uint4 w; w.x = pk2(o[0], o[1]); w.y = pk2(o[2], o[3]); w.z = pk2(o[4], o[5]); w.w = pk2(o[6], o[7]);
              *(uint4*)(MIX + (size_t)t * 2048 + c0) = w; } }
        { float4 v[8]; float ss = 0.f;
#pragma unroll
          for (int i = 0; i < 8; ++i) { v[i] = *(const float4*)(S5O + (size_t)t * 512 + i * 64 + sub * 4); ss += v[i].x * v[i].x + v[i].y * v[i].y + v[i].z * v[i].z + v[i].w * v[i].w; }
          ss += shflx(ss, 1, tid & 63); ss += shflx(ss, 2, tid & 63); ss += shflx(ss, 4, tid & 63); ss += shflx(ss, 8, tid & 63);
          const float rs = rsqrtf(ss * (1.0f / 512.0f) + EPSN);
#pragma unroll
          for (int i = 0; i < 8; ++i) { const int c0 = i * 64 + sub * 4; const float4 g = *(const float4*)(gn + 512 + c0);
              uint2 w; w.x = pk2(v[i].x * rs * g.x, v[i].y * rs * g.y); w.y = pk2(v[i].z * rs * g.z, v[i].w * rs * g.w); *(uint2*)(MIX + (size_t)t * 2048 + 512 + c0) = w; } }
#pragma unroll 1
        for (int hd = 0; hd < 4; ++hd) { float hv[16]; float ss = 0.f;
#pragma unroll
            for (int i = 0; i < 2; ++i) { const int c0 = hd * 256 + sub * 8 + 128 * i; const uint4 wf = *(const uint4*)(MLH + (size_t)t * 1024 + c0), wb = *(const uint4*)(MLH + (size_t)TOK * 1024 + (size_t)t * 1024 + c0);
                hv[i * 8 + 0] = bflo(wf.x) + bflo(wb.x); hv[i * 8 + 1] = bfhi(wf.x) + bfhi(wb.x); hv[i * 8 + 2] = bflo(wf.y) + bflo(wb.y); hv[i * 8 + 3] = bfhi(wf.y) + bfhi(wb.y);
                hv[i * 8 + 4] = bflo(wf.z) + bflo(wb.z); hv[i * 8 + 5] = bfhi(wf.z) + bfhi(wb.z); hv[i * 8 + 6] = bflo(wf.w) + bflo(wb.w); hv[i * 8 + 7] = bfhi(wf.w) + bfhi(wb.w); }
#pragma unroll
            for (int e = 0; e < 16; ++e) ss += hv[e] * hv[e];
            ss += shflx(ss, 1, tid & 63); ss += shflx(ss, 2, tid & 63); ss += shflx(ss, 4, tid & 63); ss += shflx(ss, 8, tid & 63);
            const float rs = rsqrtf(ss * (1.0f / 256.0f) + EPSN);
#pragma unroll
            for (int i = 0; i < 2; ++i) { const int c0 = hd * 256 + sub * 8 + 128 * i; const uint4 wo = *(const uint4*)(P + (size_t)t * NP + 5120 + c0);
                const float og[8] = {bflo(wo.x), bfhi(wo.x), bflo(wo.y), bfhi(wo.y), bflo(wo.z), bfhi(wo.z), bflo(wo.w), bfhi(wo.w)}; float o[8];
#pragma unroll
                for (int e = 0; e < 8; ++e) o[e] = hv[i * 8 + e] * rs * gn[1024 + c0 + e] * sigmoidf_(og[e]);
                uint4 w; w.x = pk2(o[0], o[1]); w.y = pk2(o[2], o[3]); w.z = pk2(o[4], o[5]); w.w = pk2(o[6], o[7]);
                *(uint4*)(MIX + (size_t)t * 2048 + 1024 + c0) = w; } }
    }
    __syncthreads();
}

constexpr int NTASK_ML = 24 * ML_NVS, NTASK_HY0 = 512, NTASK_HY1 = 512, NTASK_S5 = 768, NTASK_CV = CVT_ALL - CVT_EARLY, NTASK_MIX = NTASK_ML + NTASK_HY0 + NTASK_HY1 + NTASK_S5, NTASK_D = NTASK_MIX + NTASK_CV + CVT_WIN;
__device__ void mixers_phase(const Args& a, int l, unsigned char* lds, int coff, int mask = 15) {
    unsigned* ctr = (unsigned*)(a.ws + WS_CTR) + l * 64 + coff;
    volatile int* slot = (volatile int*)(lds + LDS_BYTES - 64);
    for (;;) {
        __syncthreads();
        if (launder_tid() == 0) *slot = (int)atomicAdd(ctr, 1u);
        __syncthreads();
        int task = *slot;
        if (task >= NTASK_D + (PROBE == 21 ? NTASK_S5 : 0)) break;
        if (PROBE == 21 && task >= NTASK_D) task -= NTASK_S5 + NTASK_CV + CVT_WIN;
        const int cls = task < NTASK_ML ? 1 : (task < NTASK_ML + NTASK_HY0 + NTASK_HY1 ? 2 : (task < NTASK_MIX ? 4 : 8));
        if (!(mask & cls)) continue;
        if (task < NTASK_ML) mlstm_task(a, task, lds);
        else if (task < NTASK_ML + NTASK_HY0) hyena_task<16384, 1>(a, l, task - NTASK_ML, lds);
        else if (task < NTASK_ML + NTASK_HY0 + NTASK_HY1) hyena_task<4096, 2>(a, l, task - NTASK_ML - NTASK_HY0, lds);
        else if (task < NTASK_MIX) s5_l3_task(a, l, task - (NTASK_ML + NTASK_HY0 + NTASK_HY1), lds);
        else if (task < NTASK_MIX + NTASK_CV) { __syncthreads(); convert_tile(a, l, CVT_EARLY + (task - NTASK_MIX), (float*)lds); }
        else if (l + 1 < NLAYER) { __syncthreads(); convert_tile(a, l + 1, task - NTASK_MIX - NTASK_CV, (float*)lds); }
    }
    __syncthreads();
}

#define LAS __attribute__((address_space(3)))

#define XB_TMO      128
#define XB_XCNT(j)  (256  + 64 * (j))
#define XB_XSUB(j)  (1280 + 64 * (j))
#define XB_XGEN(j)  (2304 + 64 * (j))
#define XB_TOP      3328
#define XB_TOPGEN   3392
#define XCD_BAR_WORDS 3456
#define XB_SPIN_CAP (1u << 18)

__device__ __forceinline__ unsigned xb_ld(unsigned* p)              { return __hip_atomic_load(p, __ATOMIC_RELAXED, __HIP_MEMORY_SCOPE_AGENT); }
__device__ __forceinline__ unsigned xb_add(unsigned* p, unsigned v) { return __hip_atomic_fetch_add(p, v, __ATOMIC_RELAXED, __HIP_MEMORY_SCOPE_AGENT); }
__device__ __forceinline__ unsigned xb_xcc_id() { return (unsigned)__builtin_amdgcn_s_getreg((3 << 11) | 20) & 0xFu; }
#define XB_SPIN(cond, bar) do { unsigned _sp = 0; while (cond) { __builtin_amdgcn_s_sleep(1); \
    if ((++_sp & 255u) == 0u) { if (xb_ld(&(bar)[XB_TMO])) break; if (_sp > XB_SPIN_CAP) { atomicAdd(&(bar)[XB_TMO], 1u); break; } } } } while (0)

struct XcdBarrier {
    unsigned* bar; unsigned x;
    volatile LAS unsigned* st;
};

__device__ __forceinline__ XcdBarrier xcd_barrier_post(unsigned* bar, volatile LAS unsigned* st) {
    XcdBarrier b; b.bar = bar; b.x = xb_xcc_id(); b.st = st;
    if (threadIdx.x == 0) (void)xb_add(&bar[XB_XCNT(b.x)], 1u);
    return b;
}
__device__ __forceinline__ void xcd_barrier_complete(unsigned* bar, unsigned x, unsigned& nloc, unsigned& nx) {
    const unsigned G = gridDim.x * gridDim.y * gridDim.z;
    unsigned sum, cnt, mine, sp = 0u;
    for (;;) {
        sum = 0u; cnt = 0u; mine = 0u;
#pragma unroll
        for (unsigned j = 0; j < 16; ++j) { const unsigned c = xb_ld(&bar[XB_XCNT(j)]); sum += c; cnt += (c > 0u) ? 1u : 0u; mine = (j == x) ? c : mine; }
        if (sum == G) break;
        __builtin_amdgcn_s_sleep(1);
        if ((++sp & 255u) == 0u) { if (xb_ld(&bar[XB_TMO])) break; if (sp > XB_SPIN_CAP) { atomicAdd(&bar[XB_TMO], 1u); break; } }
    }
    nloc = mine > 0u ? mine : 1u; nx = cnt > 0u ? cnt : 1u;
}

__device__ __forceinline__ void xcd_barrier(const XcdBarrier& b) {
    asm volatile("s_waitcnt vmcnt(0)" ::: "memory");
    __syncthreads();
    if (threadIdx.x == 0) {
        unsigned* bar = b.bar;
        __builtin_amdgcn_s_waitcnt(0);
        unsigned nloc = b.st[0], nx = b.st[1];
        if (nloc == 0u) { xcd_barrier_complete(bar, b.x, nloc, nx); b.st[0] = nloc; b.st[1] = nx; }
        const unsigned old = xb_add(&bar[XB_XSUB(b.x)], 1u);
        const unsigned gen = old / nloc;
        if (old + 1u == (gen + 1u) * nloc) {
            __builtin_amdgcn_fence(__ATOMIC_RELEASE, "agent");
            asm volatile("s_waitcnt vmcnt(0)" ::: "memory");
            const unsigned og = xb_add(&bar[XB_TOP], 1u);
            const unsigned tg = og / nx;
            if (og + 1u == (tg + 1u) * nx) xb_add(&bar[XB_TOPGEN], 1u);
            else XB_SPIN(xb_ld(&bar[XB_TOPGEN]) == tg, bar);
            __builtin_amdgcn_fence(__ATOMIC_ACQUIRE, "agent");
            xb_add(&bar[XB_XGEN(b.x)], 1u);
            asm volatile("s_waitcnt vmcnt(0)" ::: "memory");
        } else {
            XB_SPIN(xb_ld(&bar[XB_XGEN(b.x)]) == gen, bar);
            __builtin_amdgcn_fence(__ATOMIC_ACQUIRE, "agent");
            asm volatile("s_waitcnt vmcnt(0)" ::: "memory");
        }
    }
    __syncthreads();
}


__device__ __forceinline__ Args load_args() {
#if defined(__HIP_DEVICE_COMPILE__)
    unsigned long long p = (unsigned long long)__builtin_amdgcn_kernarg_segment_ptr();
    asm volatile("" : "+s"(p));
    return *(const __attribute__((address_space(4))) Args*)p;
#else
    return Args{};
#endif
}
#ifndef PROBE
#define PROBE 0
#endif
#define GREP(body) do { _Pragma("unroll 1") for (int rep_ = 0; rep_ < (PROBE == 1 ? 2 : 1); ++rep_) { body } } while (0)
constexpr int PH_PER_LAYER = 11, PH_TOTAL = NLAYER * PH_PER_LAYER + 1;
__global__ void __launch_bounds__(NT, 2) mk_fwd(Args a_in) {
    extern __shared__ __attribute__((aligned(16))) unsigned char lds[];
    cg::grid_group grid = cg::this_grid();
    PG8_LAS unsigned char* gl = (PG8_LAS unsigned char*)lds;
    const int lo = a_in.ph_lo, hi = a_in.ph_hi;
    const int G = (int)gridDim.x, bx = (int)blockIdx.x;
    volatile LAS unsigned* xst = (volatile LAS unsigned*)((PG8_LAS unsigned char*)lds + (LDS_BYTES - 32));
    if (threadIdx.x < 2) xst[threadIdx.x] = 0u;
    __syncthreads();
    const XcdBarrier xbar = xcd_barrier_post((unsigned*)(a_in.ws + WS_CTR + 4096), xst);
#define RUN(id) ((id) >= lo && (id) < hi)
#define SEAM(id) do { if ((id) >= lo && (id) + 1 < hi) { if ((id) == 0) grid.sync(); else xcd_barrier(xbar); } } while (0)
#pragma unroll 1
    for (int l = 0; l < NLAYER; ++l) {
        const int b = l * PH_PER_LAYER;
        if (RUN(b + 0)) { const Args a = load_args(); unsigned char* wb = a.ws + WS_WB; (void)wb; if (l == 0) rows_phase<0>(a, 0, lds); else rows_phase<2>(a, l - 1, lds); convert_weights(a, l, lds); h2_phase(a, l); }
        SEAM(b + 0);
        if (RUN(b + 1)) { const Args a = load_args(); unsigned char* wb = a.ws + WS_WB; (void)wb; pg8::Gemm g{(const bf16_t*)(a.ws + WS_H), (const bf16_t*)(wb + WB_WIN), TOK, NP, DM}; pg8::StaticOrder S; S.init(TOK, NP, G, launder_bid());
            pg8::EpiBf16X<0> E{(bf16_t*)(a.ws + WS_P), NP}; GREP(pg8::gemm_phase(gl, g, S, E);); }
        SEAM(b + 1);
#if PROBE == 2
        if (RUN(b + 2)) { const Args a = load_args(); gate_local_phase(a); conv_phase(a, l, lds); s5_l1_phase(a, l, lds); grid.sync(); sloc_phase(a); hf_phase(a, l, lds); grid.sync(); mixers_phase(a, l, lds, 16); grid.sync(); }
#endif
#if PROBE == 5 || PROBE == 7
        if (RUN(b + 2)) { const Args a = load_args(); unsigned char* wb = a.ws + WS_WB; (void)wb; gate_local_phase(a); conv_phase(a, l, lds); s5_l1_phase(a, l, lds); grid.sync(); sloc_phase(a); hf_phase(a, l, lds); grid.sync();
#if PROBE == 5
            mixers_phase(a, l, lds, 16, 2); grid.sync();
#endif
        }
#endif
        if (RUN(b + 2)) { const Args a = load_args(); unsigned char* wb = a.ws + WS_WB; (void)wb; gate_local_phase(a); conv_phase(a, l, lds); s5_l1_phase(a, l, lds);
#if PROBE == 10
            conv_phase(a, l, lds);
#elif PROBE == 12
            s5_l1_phase(a, l, lds);
#elif PROBE == 14
            gate_local_phase(a);
#endif
        }
        SEAM(b + 2);
        if (RUN(b + 3)) { const Args a = load_args(); unsigned char* wb = a.ws + WS_WB; (void)wb; sloc_phase(a); hf_phase(a, l, lds);
#if PROBE == 11
            hf_phase(a, l, lds);
#elif PROBE == 13
            sloc_phase(a);
#endif
        }
        SEAM(b + 3);
        if (RUN(b + 4)) { const Args a = load_args(); mixers_phase(a, l, lds, 0); }
        SEAM(b + 4);
        if (RUN(b + 5)) { const Args a = load_args(); unsigned char* wb = a.ws + WS_WB; (void)wb; pg8::Gemm g{(const bf16_t*)(a.ws + WS_S5Y), (const bf16_t*)(wb + WB_GLU), TOK, 1024, 512}; pg8::StaticOrder S; S.init(TOK, 1024, G, launder_bid());
            pg8::EpiGlu E{(float*)(a.ws + WS_S5O), 512, a.in[22] + l * 1024}; GREP(pg8::gemm_phase(gl, g, S, E);); }
        SEAM(b + 5);
        if (RUN(b + 6)) { const Args a = load_args(); groupnorm_phase(a, l, lds); }
        SEAM(b + 6);
        if (RUN(b + 7)) { const Args a = load_args(); unsigned char* wb = a.ws + WS_WB; (void)wb; pg8::Gemm g{(const bf16_t*)(a.ws + WS_MIX), (const bf16_t*)(wb + WB_WOUT), TOK, DM, DM}; pg8::StaticOrder S; S.init(TOK, DM, G, launder_bid());
            pg8::EpiBf16X<0> E{(bf16_t*)(a.ws + WS_TMP), DM}; GREP(pg8::gemm_phase(gl, g, S, E);); }
        SEAM(b + 7);
        if (RUN(b + 8)) { const Args a = load_args(); rows_phase<1>(a, l, lds); }
        SEAM(b + 8);
        if (RUN(b + 9)) { const Args a = load_args(); unsigned char* wb = a.ws + WS_WB; (void)wb; pg8::Gemm g{(const bf16_t*)(a.ws + WS_H), (const bf16_t*)(wb + WB_W1), TOK, DFF, DM}; pg8::StaticOrder S; S.init(TOK, DFF, G, launder_bid());
            pg8::EpiBf16X<3> E{(bf16_t*)(a.ws + WS_HID), DFF}; GREP(pg8::gemm_phase(gl, g, S, E);); }
        SEAM(b + 9);
        if (RUN(b + 10)) { const Args a = load_args(); unsigned char* wb = a.ws + WS_WB; (void)wb; pg8::Gemm g{(const bf16_t*)(a.ws + WS_HID), (const bf16_t*)(wb + WB_W2), TOK, DM, DFF}; pg8::StaticOrder S; S.init(TOK, DM, G, launder_bid());
            pg8::EpiBf16X<0> E{(bf16_t*)(a.ws + WS_TMP), DM}; GREP(pg8::gemm_phase(gl, g, S, E);); }
        SEAM(b + 10);
    }
    if (RUN(PH_TOTAL - 1)) { const Args a = load_args(); rows_phase<2>(a, NLAYER - 1, lds); }
#undef RUN
#undef SEAM
}

#ifndef MK_NLAUNCH
#define MK_NLAUNCH 1
#endif
extern "C" void kernel_launch(void* const* d_in, const int* in_sizes, int n_in, void* d_out, int out_size, void* d_ws, size_t ws_size, hipStream_t stream) {
    static int grid = 0;
    if (grid == 0) {
        int dev = 0, cus = 0, per_cu = 0;
        if (hipGetDevice(&dev) != hipSuccess || hipDeviceGetAttribute(&cus, hipDeviceAttributeMultiprocessorCount, dev) != hipSuccess) { fprintf(stderr, "device query failed\n"); grid = -1; return; }
        if (hipFuncSetAttribute((const void*)mk_fwd, hipFuncAttributeMaxDynamicSharedMemorySize, LDS_BYTES) != hipSuccess) { fprintf(stderr, "hipFuncSetAttribute failed\n"); grid = -1; return; }
        if (hipOccupancyMaxActiveBlocksPerMultiprocessor(&per_cu, (const void*)mk_fwd, NT, LDS_BYTES) != hipSuccess || per_cu < 1) fprintf(stderr, "occupancy query says %d\n", per_cu);
        (void)hipGetLastError();
        grid = cus;
        if (ws_size < WS_END || n_in != 28) { fprintf(stderr, "workspace %zu < %zu or n_in %d\n", ws_size, (size_t)WS_END, n_in); grid = -1; return; }
    }
    if (grid < 0) return;
    if (hipMemsetAsync((char*)d_ws + WS_CTR, 0, 4096 + 16384, stream) != hipSuccess) { fprintf(stderr, "memset failed\n"); return; }
    Args a{};
    for (int i = 0; i < 28; ++i) a.in[i] = (const float*)d_in[i];
    a.out = (float*)d_out; a.ws = (unsigned char*)d_ws;
    if (MK_NLAUNCH == 1) {
        a.ph_lo = 0; a.ph_hi = PH_TOTAL;
        void* args[] = {&a};
        hipError_t e = hipLaunchCooperativeKernel((const void*)mk_fwd, dim3(grid), dim3(NT), args, LDS_BYTES, stream);
        if (e != hipSuccess) fprintf(stderr, "cooperative launch failed: %s (grid %d)\n", hipGetErrorString(e), grid);
    } else {
        for (int ph = 0; ph < PH_TOTAL; ++ph) { a.ph_lo = ph; a.ph_hi = ph + 1; hipLaunchKernelGGL(mk_fwd, dim3(grid), dim3(NT), LDS_BYTES, stream, a); }
    }
}
```

```cpp
#include <hip/hip_runtime.h>
#include <hip/hip_cooperative_groups.h>
#include <cstdio>
namespace cg = cooperative_groups;
#ifndef PROBE
#define PROBE 0
#endif
__device__ __forceinline__ int launder_tid() { int t = (int)threadIdx.x; asm volatile("" : "+v"(t)); return t; }
__device__ __forceinline__ int launder_bid() { int t = (int)blockIdx.x; asm volatile("" : "+s"(t)); return t; }
namespace pg8 {
#define PG8_LAS __attribute__((address_space(3)))
typedef unsigned short bf16_t;
typedef short bf16x8 __attribute__((ext_vector_type(8)));
typedef float f32x4 __attribute__((ext_vector_type(4)));
typedef unsigned u32x4 __attribute__((ext_vector_type(4)));
constexpr int BM = 256, BK = 64, HALF = 128, HTB = HALF * BK * 2  , STAGE_BYTES = 8 * HTB, NXCD = 8, WGM = 8;

__host__ __device__ __forceinline__ int lds_byte(int r, int c) { const int st = (r >> 4) * 2 + (c >> 5), rr = r & 15, cc = c & 31, ob = rr * 64 + cc * 2; return st * 1024 + (ob ^ (((ob >> 9) & 1) << 5)); }
__host__ __device__ __forceinline__ void stage_rc(int b, int& R, int& C) { const int st = b / 1024, sb = b % 1024, swz = sb ^ (((sb >> 9) & 1) << 5); R = (st >> 1) * 16 + swz / 64; C = (st & 1) * 32 + (swz % 64) / 2; }
__host__ __device__ __forceinline__ int perm32(int rho) { const int n = rho >> 4, i = rho & 15; return 8 * (i >> 2) + 4 * n + (i & 3); }

struct Unit { int pm, pn; };
struct Gemm { const bf16_t* A; const bf16_t* Bt; int M, N, K; };

struct StaticOrder {
    int nM, nN, nwg, G, c;
    __host__ __device__ void init(int M, int N, int G_, int c_) { nM = M / BM; nN = N / BM; nwg = nM * nN; G = G_; c = c_; }
    __host__ __device__ bool next(int i, Unit& u) const {
        const long L = (long)i * G + c; if (L >= nwg) return false;
        int wgid = (int)L; { const int q = nwg / NXCD, r = nwg % NXCD, xcd = wgid % NXCD, off = wgid / NXCD; wgid = (xcd < r ? xcd * (q + 1) : r * (q + 1) + (xcd - r) * q) + off; }
        const int nig = WGM * nN, gid = wgid / nig, fm = gid * WGM, gsz = (nM - fm) < WGM ? (nM - fm) : WGM;
        u.pm = fm + ((wgid % nig) % gsz); u.pn = (wgid % nig) / gsz; return true;
    }
    __device__ __forceinline__ void a_ready(const Unit&) const {}
    __device__ __forceinline__ void done(const Unit&) const {}
};
__device__ __forceinline__ unsigned cvt_pk_bf16(float lo, float hi) { unsigned r; asm volatile("v_cvt_pk_bf16_f32 %0, %1, %2" : "=v"(r) : "v"(lo), "v"(hi)); return r; }
typedef float f32x2 __attribute__((ext_vector_type(2)));
__device__ __forceinline__ f32x2 gelu_pk(f32x2 v) {
    const f32x2 av = __builtin_elementwise_abs(v), d = av * 0.2316418882f + 1.0f;
    f32x2 t; t.x = __builtin_amdgcn_rcpf(d.x); t.y = __builtin_amdgcn_rcpf(d.y);
    f32x2 q = t * 0.5307027145f + (-0.7265760135f); q = q * t + 0.7107068705f; q = q * t + (-0.142248368f); q = q * t + 0.127414796f; q = q * t;
    const f32x2 s = (v * v) * (-0.72134752044f);
    f32x2 e; e.x = __builtin_amdgcn_exp2f(s.x); e.y = __builtin_amdgcn_exp2f(s.y);
    const f32x2 m = v * (q * e), r = v - m;
    f32x2 o; o.x = v.x < 0.f ? m.x : r.x; o.y = v.y < 0.f ? m.y : r.y; return o;
}

struct EpiF32 {
    static constexpr bool PERM = false, AFTER_DRAIN = false;
    float* C; int ldc; const float* bias;
    __device__ __forceinline__ void operator()(const f32x4 (&acc)[2][2][4][2], const Unit& u, int wr, int wc, int fr, int fq) const {
        const int row0 = u.pm * BM + wr * 64 + fr, col0 = u.pn * BM + wc * 32 + 4 * fq;
        f32x4 bv[2][2];
#pragma unroll
        for (int bj = 0; bj < 2; ++bj)
#pragma unroll
            for (int n = 0; n < 2; ++n) bv[bj][n] = bias ? *(const f32x4*)(bias + col0 + bj * HALF + n * 16) : (f32x4){0.f, 0.f, 0.f, 0.f};
#pragma unroll
        for (int ai = 0; ai < 2; ++ai)
#pragma unroll
            for (int m = 0; m < 4; ++m) { float* rowp = C + (size_t)(row0 + ai * HALF + m * 16) * ldc + col0;
#pragma unroll
                for (int bj = 0; bj < 2; ++bj)
#pragma unroll
                    for (int n = 0; n < 2; ++n) *(f32x4*)(rowp + bj * HALF + n * 16) = acc[ai][bj][m][n] + bv[bj][n]; }
    }
};
template <int ACT  > struct EpiBf16 {
    static constexpr bool PERM = true, AFTER_DRAIN = false;
    bf16_t* O; int ldc; const float* bias; int split_cols; size_t split_stride;
    __device__ __forceinline__ void operator()(const f32x4 (&acc)[2][2][4][2], const Unit& u, int wr, int wc, int fr, int fq) const {
        const int row0 = u.pm * BM + wr * 64 + fr; int colt = u.pn * BM; bf16_t* base = O;
        if (split_cols) { const int t = colt / split_cols; base += (size_t)t * split_stride; colt -= t * split_cols; }
        const int col0 = colt + wc * 32 + 8 * fq, bcol0 = u.pn * BM + wc * 32 + 8 * fq;
        f32x4 bv[2][2];
#pragma unroll
        for (int bj = 0; bj < 2; ++bj)
#pragma unroll
            for (int n = 0; n < 2; ++n) bv[bj][n] = bias ? *(const f32x4*)(bias + bcol0 + bj * HALF + 4 * n) : (f32x4){0.f, 0.f, 0.f, 0.f};
#pragma unroll
        for (int ai = 0; ai < 2; ++ai)
#pragma unroll
            for (int m = 0; m < 4; ++m) { bf16_t* rowp = base + (size_t)(row0 + ai * HALF + m * 16) * ldc + col0;
#pragma unroll
                for (int bj = 0; bj < 2; ++bj) { f32x4 v0 = acc[ai][bj][m][0] + bv[bj][0], v1 = acc[ai][bj][m][1] + bv[bj][1];
                    if (ACT == 1) { f32x2 a = gelu_pk((f32x2){v0[0], v0[1]}), b = gelu_pk((f32x2){v0[2], v0[3]}), c = gelu_pk((f32x2){v1[0], v1[1]}), d = gelu_pk((f32x2){v1[2], v1[3]});
                        v0 = (f32x4){a.x, a.y, b.x, b.y}; v1 = (f32x4){c.x, c.y, d.x, d.y}; }
                    if (ACT == 2) {
#pragma unroll
                        for (int j = 0; j < 4; ++j) { v0[j] = 0.5f * v0[j] * (1.0f + erff(v0[j] * 0.70710678f)); v1[j] = 0.5f * v1[j] * (1.0f + erff(v1[j] * 0.70710678f)); } }
                    u32x4 w; w.x = cvt_pk_bf16(v0[0], v0[1]); w.y = cvt_pk_bf16(v0[2], v0[3]); w.z = cvt_pk_bf16(v1[0], v1[1]); w.w = cvt_pk_bf16(v1[2], v1[3]);
                    *(u32x4*)(rowp + bj * HALF) = w; } }
    }
};
template <int ACT> struct EpiBf16X {
    static constexpr bool PERM = true, AFTER_DRAIN = false;
    bf16_t* O; int ldc;
    __device__ __forceinline__ void operator()(const f32x4 (&acc)[2][2][4][2], const Unit& u, int wr, int wc, int fr, int fq) const {
        const int row0 = u.pm * BM + wr * 64 + fr; const int col0 = u.pn * BM + wc * 32 + 8 * fq;
#pragma unroll
        for (int ai = 0; ai < 2; ++ai)
#pragma unroll
            for (int m = 0; m < 4; ++m) { bf16_t* rowp = O + (size_t)(row0 + ai * HALF + m * 16) * ldc + col0;
#pragma unroll
                for (int bj = 0; bj < 2; ++bj) { f32x4 v0 = acc[ai][bj][m][0], v1 = acc[ai][bj][m][1];
                    if (ACT == 3) {
#pragma unroll
                        for (int j = 0; j < 4; ++j) { float a = fmaxf(v0[j], 0.f), b = fmaxf(v1[j], 0.f); v0[j] = a * a; v1[j] = b * b; } }
                    u32x4 w; w.x = cvt_pk_bf16(v0[0], v0[1]); w.y = cvt_pk_bf16(v0[2], v0[3]); w.z = cvt_pk_bf16(v1[0], v1[1]); w.w = cvt_pk_bf16(v1[2], v1[3]);
                    *(u32x4*)(rowp + bj * HALF) = w; } }
    }
};
struct EpiGlu {
    static constexpr bool PERM = false, AFTER_DRAIN = false;
    float* C; int ldc; const float* bias;
    __device__ __forceinline__ void operator()(const f32x4 (&acc)[2][2][4][2], const Unit& u, int wr, int wc, int fr, int fq) const {
        const int row0 = u.pm * BM + wr * 64 + fr, col0 = u.pn * HALF + wc * 32 + 4 * fq;
#pragma unroll
        for (int n = 0; n < 2; ++n) { const f32x4 bv = *(const f32x4*)(bias + col0 + n * 16), bg = *(const f32x4*)(bias + 512 + col0 + n * 16);
#pragma unroll
            for (int ai = 0; ai < 2; ++ai)
#pragma unroll
                for (int m = 0; m < 4; ++m) { float* p = C + (size_t)(row0 + ai * HALF + m * 16) * ldc + col0 + n * 16;
                    const f32x4 v = acc[ai][0][m][n] + bv, g = acc[ai][1][m][n] + bg; f32x4 o;
#pragma unroll
                    for (int j = 0; j < 4; ++j) o[j] = v[j] / (1.0f + __expf(-g[j]));
                    *(f32x4*)p = o; } }
    }
};
template <class Epi, class Sched>
__device__ __forceinline__ void gemm_phase(PG8_LAS unsigned char* lds, const Gemm g, const Sched& S, const Epi& E) {
    const int tid = launder_tid(), wid = __builtin_amdgcn_readfirstlane(tid >> 6), lane = tid & 63, wr = wid >> 2, wc = wid & 3, fr = lane & 15, fq = lane >> 4;
    const int K = g.K, nt = K / BK;
    unsigned voffA[2], voffB[2];
#pragma unroll
    for (int i = 0; i < 2; ++i) { int R, C; stage_rc(tid * 16 + i * 8192, R, C); const int Rb = Epi::PERM ? ((R & ~31) + perm32(R & 31)) : R;
        voffA[i] = (unsigned)(R * K + C) * 2u; voffB[i] = (unsigned)(Rb * K + C) * 2u; }
    const size_t kstep = (size_t)(BK * 2);
    const size_t hstep = (size_t)HALF * K * 2;
    const size_t tstep = 2 * hstep;
    const unsigned ldsw = (unsigned)wid * 1024u;
    const int aoff = lds_byte(wr * 64 + fr, fq * 8), boff = lds_byte(wc * 32 + fr, fq * 8);
#define PG8_SA(b, h) (((b) * 2 + (h)) * HTB)
#define PG8_SB(b, h) ((4 + (b) * 2 + (h)) * HTB)
#define PG8_STAGE(bufoff, gbase, voff) do { _Pragma("unroll") for (int _i = 0; _i < 2; ++_i) \
        __builtin_amdgcn_global_load_lds((const unsigned*)((const char*)(gbase) + (voff)[_i]), (PG8_LAS unsigned*)(lds + (bufoff) + ldsw + _i * 8192), 16, 0, 0); } while (0)
#define PG8_LDA(dst, b, h) do { _Pragma("unroll") for (int m = 0; m < 4; ++m) _Pragma("unroll") for (int k = 0; k < 2; ++k) dst[m][k] = *(const PG8_LAS bf16x8*)(lds + PG8_SA(b, h) + aoff + m * 2048 + k * 1024); } while (0)
#define PG8_LDB(dst, b, h) do { _Pragma("unroll") for (int n = 0; n < 2; ++n) _Pragma("unroll") for (int k = 0; k < 2; ++k) dst[n][k] = *(const PG8_LAS bf16x8*)(lds + PG8_SB(b, h) + boff + n * 2048 + k * 1024); } while (0)
#define PG8_MMA(ai, bj, At, Bt) do { __builtin_amdgcn_s_setprio(1); _Pragma("unroll") for (int m = 0; m < 4; ++m) _Pragma("unroll") for (int n = 0; n < 2; ++n) _Pragma("unroll") for (int k = 0; k < 2; ++k) \
        acc[ai][bj][m][n] = __builtin_amdgcn_mfma_f32_16x16x32_bf16(Bt[n][k], At[m][k], acc[ai][bj][m][n], 0, 0, 0); __builtin_amdgcn_s_setprio(0); } while (0)
#define PG8_WAIT_V(n) asm volatile("s_waitcnt vmcnt(" #n ")" ::: "memory")
#define PG8_WAIT_L(n) asm volatile("s_waitcnt lgkmcnt(" #n ")" ::: "memory")
#define PG8_BAR __builtin_amdgcn_s_barrier()
#define PG8_SCHED __builtin_amdgcn_sched_barrier(0)
    Unit cur, nxt; int ui = 0;
    if (!S.next(0, cur)) return;
    f32x4 acc[2][2][4][2];
#pragma unroll
    for (int a = 0; a < 2; ++a)
#pragma unroll
        for (int b = 0; b < 2; ++b)
#pragma unroll
            for (int m = 0; m < 4; ++m)
#pragma unroll
                for (int n = 0; n < 2; ++n) acc[a][b][m][n] = (f32x4){0.f, 0.f, 0.f, 0.f};
    bf16x8 At[4][2], B0[2][2], B1[2][2];
    const char* cA = (const char*)g.A + (size_t)cur.pm * tstep; const char* cB = (const char*)g.Bt + (size_t)cur.pn * tstep;
    S.a_ready(cur);
    PG8_STAGE(PG8_SB(0, 0), cB, voffB); PG8_STAGE(PG8_SA(0, 0), cA, voffA); PG8_STAGE(PG8_SB(0, 1), cB + hstep, voffB); PG8_STAGE(PG8_SA(0, 1), cA + hstep, voffA);
    if (wr == 1) PG8_BAR;
    PG8_WAIT_V(4); PG8_BAR;
    PG8_STAGE(PG8_SB(1, 0), cB + kstep, voffB); PG8_STAGE(PG8_SA(1, 0), cA + kstep, voffA); PG8_STAGE(PG8_SB(1, 1), cB + hstep + kstep, voffB);
    PG8_WAIT_V(6); PG8_BAR;
    for (;;) {
        const bool has_next = S.next(ui + 1, nxt);
        const char* nA = has_next ? (const char*)g.A + (size_t)nxt.pm * tstep : cA; const char* nB = has_next ? (const char*)g.Bt + (size_t)nxt.pn * tstep : cB;
        for (int t = 0; t < nt; t += 2) {
            const bool last = (t == nt - 2);
            const char* a1 = cA + (size_t)(t + 1) * kstep;
            const char* a2 = last ? nA : cA + (size_t)(t + 2) * kstep; const char* b2 = last ? nB : cB + (size_t)(t + 2) * kstep;
            const char* a3 = a2 + kstep; const char* b3 = b2 + kstep;
            if (last && has_next) S.a_ready(nxt);
            PG8_LDB(B0, 0, 0); PG8_SCHED; PG8_LDA(At, 0, 0); PG8_STAGE(PG8_SA(1, 1), a1 + hstep, voffA);
            PG8_WAIT_L(8); PG8_BAR; PG8_WAIT_L(0); PG8_MMA(0, 0, At, B0); PG8_BAR; PG8_SCHED;
            PG8_LDB(B1, 0, 1); PG8_STAGE(PG8_SB(0, 0), b2, voffB);
            PG8_BAR; PG8_WAIT_L(0); PG8_MMA(0, 1, At, B1); PG8_BAR;
            PG8_LDA(At, 0, 1); PG8_STAGE(PG8_SA(0, 0), a2, voffA);
            PG8_BAR; PG8_WAIT_L(0); PG8_MMA(1, 0, At, B0); PG8_BAR; PG8_SCHED;
            PG8_STAGE(PG8_SB(0, 1), b2 + hstep, voffB);
            PG8_WAIT_V(6); PG8_BAR; PG8_MMA(1, 1, At, B1); PG8_BAR;
            PG8_LDB(B0, 1, 0); PG8_SCHED; PG8_LDA(At, 1, 0); PG8_STAGE(PG8_SA(0, 1), a2 + hstep, voffA);
            PG8_WAIT_L(8); PG8_BAR; PG8_WAIT_L(0); PG8_MMA(0, 0, At, B0); PG8_BAR; PG8_SCHED;
            PG8_LDB(B1, 1, 1); PG8_STAGE(PG8_SB(1, 0), b3, voffB);
            PG8_BAR; PG8_WAIT_L(0); PG8_MMA(0, 1, At, B1); PG8_BAR;
            PG8_LDA(At, 1, 1); PG8_STAGE(PG8_SA(1, 0), a3, voffA);
            PG8_BAR; PG8_WAIT_L(0); PG8_MMA(1, 0, At, B0); PG8_BAR; PG8_SCHED;
            PG8_STAGE(PG8_SB(1, 1), b3 + hstep, voffB);
            PG8_WAIT_V(6); PG8_BAR; PG8_MMA(1, 1, At, B1); PG8_BAR;
        }
        if constexpr (!Epi::AFTER_DRAIN) { E(acc, cur, wr, wc, fr, fq); S.done(cur); }
        if (!has_next) break;
#pragma unroll
        for (int a = 0; a < 2; ++a)
#pragma unroll
            for (int b = 0; b < 2; ++b)
#pragma unroll
                for (int m = 0; m < 4; ++m)
#pragma unroll
                    for (int n = 0; n < 2; ++n) acc[a][b][m][n] = (f32x4){0.f, 0.f, 0.f, 0.f};
        cur = nxt; cA = nA; cB = nB; ++ui;
    }
    PG8_WAIT_V(0);
    if (wr == 0) PG8_BAR;
    PG8_BAR;
    if constexpr (Epi::AFTER_DRAIN) { E.fused(acc, cur, wr, wc, fr, fq, lds, wid, lane); S.done(cur); }
#undef PG8_SA
#undef PG8_SB
#undef PG8_STAGE
#undef PG8_LDA
#undef PG8_LDB
#undef PG8_MMA
#undef PG8_WAIT_V
#undef PG8_WAIT_L
#undef PG8_BAR
#undef PG8_SCHED
}
}

typedef unsigned short bf16_t;
typedef short bf16x8 __attribute__((ext_vector_type(8)));
typedef float f32x4 __attribute__((ext_vector_type(4)));
constexpr int NT = 512;
constexpr int LDS_BYTES = 136 * 1024;
constexpr int TOK = 24576, DM = 2048, PIN = 6160, NP = 6144, DFF = 8192;
constexpr int NLAYER = 4;
constexpr float EPSN = 1e-6f;
constexpr size_t MiB = 1024 * 1024;
constexpr size_t WS_WB = 0;
constexpr size_t WB_WIN = 0, WB_GLU = WB_WIN + (size_t)NP * DM * 2, WB_WOUT = WB_GLU + (size_t)1024 * 512 * 2, WB_W1 = WB_WOUT + (size_t)DM * DM * 2, WB_W2 = WB_W1 + (size_t)DFF * DM * 2;
static_assert(WB_W2 + (size_t)DFF * DM * 2 <= 97 * MiB, "wb");
constexpr size_t WS_H = 97 * MiB;
constexpr size_t WS_P = 193 * MiB;
constexpr size_t WS_TMP = 193 * MiB;
constexpr size_t WS_HID = 385 * MiB;
constexpr size_t WS_HYIN = 481 * MiB;
constexpr size_t WS_QK = 625 * MiB;
constexpr size_t WS_MIX = 625 * MiB;
constexpr size_t WS_MLH = 721 * MiB;
constexpr size_t WS_S5Y = 817 * MiB;
constexpr size_t WS_S5O = 841 * MiB;
constexpr size_t WS_SCR = 889 * MiB;
constexpr size_t WS_H2T = 921 * MiB;
constexpr size_t WS_G = 926 * MiB;
constexpr size_t WS_FIN = 928 * MiB;
constexpr size_t WS_CTR = 935 * MiB;
constexpr size_t WS_HF0 = WS_H;
constexpr size_t WS_HF1 = WS_H + 40 * MiB;
constexpr size_t WS_VT = WS_S5O;
constexpr size_t WS_KT = 936 * MiB;
constexpr size_t WS_SL = 984 * MiB;
constexpr size_t WS_BJ = 1008 * MiB;
constexpr size_t WS_PMJ = WS_BJ + (size_t)8 * 24576 * 4;
constexpr size_t WS_LOC = WS_PMJ + (size_t)8 * 24576 * 4;
constexpr size_t WS_BLML = WS_LOC + (size_t)8 * 24576 * 4;
constexpr size_t WS_WL = WS_BLML + 64 * 1024;
constexpr size_t WS_END = 1012 * MiB;
static_assert(WS_WL + (size_t)8 * 24576 * 4 <= WS_END, "ws map");
constexpr size_t HF_G1 = (size_t)2 * 512 * 16384;

struct Args { const float* in[28]; float* out; unsigned char* ws; int ph_lo, ph_hi; };

typedef __bf16 bf16x2n_t __attribute__((ext_vector_type(2)));
__device__ __forceinline__ unsigned pk2(float lo, float hi) { bf16x2n_t v; v[0] = (__bf16)lo; v[1] = (__bf16)hi; return __builtin_bit_cast(unsigned, v); }
__device__ __forceinline__ bf16_t f2bf(float f) { return __builtin_bit_cast(bf16_t, (__bf16)f); }
__device__ __forceinline__ float bf2f(bf16_t b) { return __uint_as_float(((unsigned)b) << 16); }
__device__ __forceinline__ float bflo(unsigned w) { return __uint_as_float(w << 16); }
__device__ __forceinline__ float bfhi(unsigned w) { return __uint_as_float(w & 0xffff0000u); }
__device__ __forceinline__ float sinr(float x) { return __builtin_amdgcn_sinf(x); }
__device__ __forceinline__ float cosr(float x) { return __builtin_amdgcn_cosf(x); }
__device__ __forceinline__ float my_shfl(float v, int src) { return __int_as_float(__builtin_amdgcn_ds_bpermute(src << 2, __float_as_int(v))); }
__device__ __forceinline__ float shflx(float v, int o, int lane) { return my_shfl(v, lane ^ o); }
__device__ __forceinline__ float my_shfl_up(float v, int o, int lane) { return my_shfl(v, lane - o); }
__device__ __forceinline__ float wave_sum(float v) { const int lane = launder_tid() & 63;
#pragma unroll
    for (int o = 32; o >= 1; o >>= 1) v += shflx(v, o, lane);
    return v; }
__device__ __forceinline__ float wave_max(float v) { const int lane = launder_tid() & 63;
#pragma unroll
    for (int o = 32; o >= 1; o >>= 1) v = fmaxf(v, shflx(v, o, lane));
    return v; }
__device__ __forceinline__ float sigmoidf_(float x) { return 1.0f / (1.0f + __expf(-x)); }
__device__ __forceinline__ bool seq_first(int t) { return t == 0 || t == 16384 || t == 20480; }
__device__ __forceinline__ bool seq_last(int t) { return t == 16383 || t == 20479 || t == 24575; }

__device__ __forceinline__ void cvt_tile(const float* __restrict__ src, int ldsrc, int k0, int srccol0, bf16_t* __restrict__ dst, int K, int n0, float* tl) {
    const int tid = launder_tid();
#pragma unroll
    for (int i = 0; i < 8; ++i) { const int kk = (tid >> 4) + 32 * i, nn4 = (tid & 15) * 4;
        const float4 v = *(const float4*)(src + (size_t)(k0 + kk) * ldsrc + srccol0 + nn4);
        tl[(nn4 + 0) * 257 + kk] = v.x; tl[(nn4 + 1) * 257 + kk] = v.y; tl[(nn4 + 2) * 257 + kk] = v.z; tl[(nn4 + 3) * 257 + kk] = v.w; }
    __syncthreads();
#pragma unroll
    for (int i = 0; i < 4; ++i) { const int item = i * NT + tid, nn = item >> 5, ks = (item & 31) * 8; const float* r = tl + nn * 257 + ks;
      uint4 w; w.x = pk2(r[0], r[1]); w.y = pk2(r[2], r[3]); w.z = pk2(r[4], r[5]); w.w = pk2(r[6], r[7]);
      *(uint4*)(dst + (size_t)(n0 + nn) * K + k0 + ks) = w; }
    __syncthreads();
}
constexpr int CVT_EARLY = 768 + 32 + 256, CVT_ALL = CVT_EARLY + 2048;
__device__ __forceinline__ void convert_tile(const Args& a, int l, int t, float* tl);
constexpr int CVT_WIN = 768;
__device__ __forceinline__ void convert_weights(const Args& a, int l, unsigned char* lds) {
    for (int t = launder_bid() + (l == 0 ? 0 : CVT_WIN); t < CVT_EARLY; t += gridDim.x) convert_tile(a, l, t, (float*)lds);
}
__device__ __forceinline__ void convert_tile(const Args& a, int l, int t, float* tl) {
    unsigned char* wb = a.ws + WS_WB;
    const int T0 = 768, T1 = T0 + 32, T2 = T1 + 256, T3 = T2 + 1024;
    {
        if (t < T0) { const int kt = t & 7, ntile = t >> 3; cvt_tile(a.in[3] + (size_t)l * DM * PIN, PIN, kt * 256, ntile * 64, (bf16_t*)(wb + WB_WIN), DM, ntile * 64, tl); }
        else if (t < T1) { const int u = t - T0, kt = u & 1, ntile = u >> 1; const int n0 = ntile * 64, pn = n0 >> 8, bj = (n0 >> 7) & 1, cc = n0 & 127;
            cvt_tile(a.in[21] + (size_t)l * 512 * 1024, 1024, kt * 256, 512 * bj + 128 * pn + cc, (bf16_t*)(wb + WB_GLU), 512, n0, tl); }
        else if (t < T2) { const int u = t - T1, kt = u & 7, ntile = u >> 3; cvt_tile(a.in[25] + (size_t)l * DM * DM, DM, kt * 256, ntile * 64, (bf16_t*)(wb + WB_WOUT), DM, ntile * 64, tl); }
        else if (t < T3) { const int u = t - T2, kt = u & 7, ntile = u >> 3; cvt_tile(a.in[26] + (size_t)l * DM * DFF, DFF, kt * 256, ntile * 64, (bf16_t*)(wb + WB_W1), DM, ntile * 64, tl); }
        else { const int u = t - T3, kt = u & 31, ntile = u >> 5; cvt_tile(a.in[27] + (size_t)l * DFF * DM, DM, kt * 256, ntile * 64, (bf16_t*)(wb + WB_W2), DFF, ntile * 64, tl); }
    }
}

__device__ __forceinline__ void h2_phase(const Args& a, int l) {
    const int lane = launder_tid() & 63, wv = launder_tid() >> 6;
    const float* w1 = a.in[6] + (size_t)l * 33 * 64; const float* b1 = a.in[7] + l * 64; const float* fq = a.in[8] + l * 64;
    const float* w2 = a.in[9] + (size_t)l * 64 * 64; const float* b2 = a.in[10] + l * 64;
    float* H2T = (float*)(a.ws + WS_H2T);
    const float frj = fq[lane], b1j = b1[lane], b2j = b2[lane];
    for (int idx = launder_bid() * 8 + wv; idx < 20480; idx += gridDim.x * 8) {
        const int L = idx < 16384 ? 16384 : 4096, n = idx < 16384 ? idx : idx - 16384;
        const float t = (float)n / (float)(L - 1), w = 6.283185307179586f * (float)n / (float)L;
        float zv = 0.f;
        if (lane == 0) zv = t;
        else if (lane <= 32) { const int i = (lane - 1) & 15; const float f = 1e-4f + (float)i * ((15.0f - 1e-4f) / 15.0f); const float ar = f * w; zv = lane <= 16 ? cosf(ar) : -sinf(ar); }
        float pre = b1j;
        for (int k = 0; k < 33; ++k) pre += my_shfl(zv, k) * w1[k * 64 + lane];
        const float h1 = sinf(frj * pre);
        float pre2 = b2j;
        for (int k = 0; k < 64; ++k) pre2 += my_shfl(h1, k) * w2[k * 64 + lane];
        const float h2 = sinf(frj * pre2);
        float* dst = idx < 16384 ? H2T + (size_t)lane * 16384 + n : H2T + (size_t)64 * 16384 + (size_t)lane * 4096 + n;
        *dst = h2;
    }
}

template <int MODE>
__device__ __forceinline__ void rows_phase(const Args& a, int l, unsigned char* lds) {
    const int tid = launder_tid(), lane = tid & 63, wv = tid >> 6;
    const bool do_gates = (MODE == 0) || (MODE == 2 && l + 1 < NLAYER);
    const bool do_h = (MODE != 2) || (l + 1 < NLAYER);
    const int ln = (MODE == 2) ? l + 1 : l;
    float* Wg = (float*)lds;
    if (do_gates) {
        const float* wsrc = a.in[3] + (size_t)ln * DM * PIN + NP;
        for (int it = tid; it < 2048 * 4; it += NT) { const int k = it >> 2, j4 = (it & 3) * 4; const float4 v = *(const float4*)(wsrc + (size_t)k * PIN + j4);
            Wg[(j4 + 0) * 2048 + k] = v.x; Wg[(j4 + 1) * 2048 + k] = v.y; Wg[(j4 + 2) * 2048 + k] = v.z; Wg[(j4 + 3) * 2048 + k] = v.w; }
        __syncthreads();
    }
    const float* gA = a.in[2] + (size_t)(l * 4 + (MODE == 1 ? 1 : 3)) * DM;
    const float* gH = a.in[2] + (size_t)(MODE == 1 ? l * 4 + 2 : ln * 4 + 0) * DM;
    const bf16_t* TMPp = (const bf16_t*)(a.ws + WS_TMP);
    bf16_t* H = (bf16_t*)(a.ws + WS_H); float* G = (float*)(a.ws + WS_G);
    const float* gb = a.in[23] + ln * 16;
    for (int row = launder_bid() * 8 + wv; row < TOK; row += gridDim.x * 8) {
        float4 x[8];
        float* xo = a.out + (size_t)row * DM;
        if (MODE == 0) { const float* xi = row < 16384 ? a.in[0] + (size_t)row * DM : a.in[1] + (size_t)(row - 16384) * DM;
#pragma unroll
            for (int i = 0; i < 8; ++i) { x[i] = *(const float4*)(xi + i * 256 + lane * 4); *(float4*)(xo + i * 256 + lane * 4) = x[i]; }
        } else {
            float4 tv[8]; float ss = 0.f; const bf16_t* tp = TMPp + (size_t)row * DM;
#pragma unroll
            for (int i = 0; i < 8; ++i) { const uint2 w = *(const uint2*)(tp + i * 256 + lane * 4); tv[i] = make_float4(bflo(w.x), bfhi(w.x), bflo(w.y), bfhi(w.y)); ss += tv[i].x * tv[i].x + tv[i].y * tv[i].y + tv[i].z * tv[i].z + tv[i].w * tv[i].w; }
            ss = wave_sum(ss); const float rs = rsqrtf(ss * (1.0f / DM) + EPSN);
#pragma unroll
            for (int i = 0; i < 8; ++i) { const float4 g = *(const float4*)(gA + i * 256 + lane * 4); float4 xv = *(const float4*)(xo + i * 256 + lane * 4);
                xv.x += tv[i].x * rs * g.x; xv.y += tv[i].y * rs * g.y; xv.z += tv[i].z * rs * g.z; xv.w += tv[i].w * rs * g.w; x[i] = xv; *(float4*)(xo + i * 256 + lane * 4) = xv; }
        }
        if (do_h) {
            float ss = 0.f;
#pragma unroll
            for (int i = 0; i < 8; ++i) ss += x[i].x * x[i].x + x[i].y * x[i].y + x[i].z * x[i].z + x[i].w * x[i].w;
            ss = wave_sum(ss); const float rs = rsqrtf(ss * (1.0f / DM) + EPSN);
            bf16_t* hp = H + (size_t)row * DM;
#pragma unroll
            for (int i = 0; i < 8; ++i) { const float4 g = *(const float4*)(gH + i * 256 + lane * 4);
                x[i].x *= rs * g.x; x[i].y *= rs * g.y; x[i].z *= rs * g.z; x[i].w *= rs * g.w;
                uint2 w; w.x = pk2(x[i].x, x[i].y); w.y = pk2(x[i].z, x[i].w); *(uint2*)(hp + i * 256 + lane * 4) = w; }
            if (do_gates) {
                float mine = 0.f;
#pragma unroll 1
                for (int j = 0; j < 16; ++j) { float p = 0.f;
#pragma unroll
                    for (int i = 0; i < 8; ++i) { const float4 wv4 = *(const float4*)(Wg + j * 2048 + i * 256 + lane * 4); p += x[i].x * wv4.x + x[i].y * wv4.y + x[i].z * wv4.z + x[i].w * wv4.w; }
                    p = wave_sum(p); if (lane == j) mine = p; }
                if (lane < 16) G[(size_t)row * 16 + lane] = mine + gb[lane];
            }
        }
    }
    __syncthreads();
}

__device__ __forceinline__ void conv_decode(int u, int& tt0, int& pc0, int& kind) {
    tt0 = (u / 14) * 64; const int ct = u % 14;
    if (ct < 6) { kind = 0; pc0 = ct * 256; } else if (ct < 10) { kind = 1; pc0 = 2560 + (ct - 6) * 256; } else { kind = 2; pc0 = 4096 + (ct - 10) * 256; }
}
__device__ __forceinline__ void conv_load(const bf16_t* P, int tt0, int pc0, int tid, uint4 (&w)[5]) {
    const bool first = seq_first(tt0), last = seq_last(tt0 + 63);
#pragma unroll
    for (int i = 0; i < 5; ++i) { const int it = tid + i * NT; w[i] = (uint4){0u, 0u, 0u, 0u};
        if (it < 66 * 32) { const int r = it >> 5, sg = it & 31; const bool valid = !((r == 0 && first) || (r == 65 && last));
            if (valid) w[i] = *(const uint4*)(P + (size_t)(tt0 - 1 + r) * NP + pc0 + sg * 8); } }
}
__device__ __forceinline__ void conv_stage(bf16_t* tin, int tid, const uint4 (&w)[5]) {
#pragma unroll
    for (int i = 0; i < 5; ++i) { const int it = tid + i * NT;
        if (it < 66 * 32) { const int r = it >> 5, sg = it & 31; *(uint4*)(tin + r * 264 + sg * 8) = w[i]; } }
}
template <int KIND>
__device__ __forceinline__ void conv_compute(const Args& a, int l, int pc0, int tid, const bf16_t* tin, float* tout) {
    const float* cw = a.in[4] + (size_t)l * 3 * 3584; const float* cb = a.in[5] + (size_t)l * 3584;
    const int cc = tid & 255, t0 = (tid >> 8) * 32, c = pc0 + cc;
    float w0 = 0.f, w1 = 0.f, w2 = 0.f, bias = 0.f;
    if (KIND != 2) { bias = cb[c]; w0 = cw[c]; w1 = cw[3584 + c]; w2 = cw[2 * 3584 + c]; }
    float pv = bf2f(tin[t0 * 264 + cc]), cv = bf2f(tin[(t0 + 1) * 264 + cc]);
#pragma unroll 8
    for (int e = 0; e < 32; ++e) { const int tt = t0 + e; const float nv = bf2f(tin[(tt + 2) * 264 + cc]); float v;
        if (KIND == 2) v = cv;
        else { v = bias + w0 * pv + w1 * cv + w2 * nv; if (KIND == 1) v = v / (1.0f + __expf(-v)) * 0.0625f; }
        tout[cc * 65 + tt] = v; pv = cv; cv = nv; }
}
template <int KIND>
__device__ __forceinline__ void conv_store(const Args& a, int tt0, int pc0, int tid, const float* tout) {
#pragma unroll
    for (int it = 0; it < 4; ++it) { const int cc = (tid >> 3) + 64 * it, ts = (tid & 7) * 8; const float* r = tout + cc * 65 + ts;
      if (KIND == 0) { float* d = (float*)(a.ws + WS_HYIN) + (size_t)(pc0 + cc) * TOK + tt0 + ts; *(float4*)d = make_float4(r[0], r[1], r[2], r[3]); *(float4*)(d + 4) = make_float4(r[4], r[5], r[6], r[7]); }
      else { bf16_t* d = (bf16_t*)(a.ws + (KIND == 1 ? WS_KT : WS_VT)) + (size_t)(pc0 - (KIND == 1 ? 2560 : 4096) + cc) * TOK + tt0 + ts;
          uint4 w; w.x = pk2(r[0], r[1]); w.y = pk2(r[2], r[3]); w.z = pk2(r[4], r[5]); w.w = pk2(r[6], r[7]); *(uint4*)d = w; } }
    if (KIND == 1) {
#pragma unroll
        for (int it = 0; it < 4; ++it) { const int item = it * NT + tid, tt = item >> 5, cs = (item & 31) * 8; const float* r = tout + cs * 65 + tt;
            uint4 w; w.x = pk2(r[0], r[65]); w.y = pk2(r[130], r[195]); w.z = pk2(r[260], r[325]); w.w = pk2(r[390], r[455]);
            *(uint4*)((bf16_t*)(a.ws + WS_QK) + (size_t)(tt0 + tt) * 2048 + (pc0 - 1536) + cs) = w; } }
}
__device__ __forceinline__ void conv_phase(const Args& a, int l, unsigned char* lds) {
    const int tid = launder_tid();
    const bf16_t* P = (const bf16_t*)(a.ws + WS_P);
    const float* cw = a.in[4] + (size_t)l * 3 * 3584; const float* cb = a.in[5] + (size_t)l * 3584;
    bf16_t* QK = (bf16_t*)(a.ws + WS_QK);
    bf16_t* tin = (bf16_t*)lds;
    float* tout = (float*)(lds + 66 * 264 * 2);
    constexpr int NTILE = 384 * 14;
    const int G = (int)gridDim.x;
    uint4 wreg[5];
    { const int u0 = launder_bid(); if (u0 < NTILE) { int tt0, pc0, kind; conv_decode(u0, tt0, pc0, kind); conv_load(P, tt0, pc0, tid, wreg); } }
    for (int u = launder_bid(); u < NTILE; u += G) {
        int tt0, pc0, kind; conv_decode(u, tt0, pc0, kind);
        conv_stage(tin, tid, wreg);
        __syncthreads();
        if (u + G < NTILE) { int tn, pn, kn; conv_decode(u + G, tn, pn, kn); conv_load(P, tn, pn, tid, wreg); }
        if (kind == 0) conv_compute<0>(a, l, pc0, tid, tin, tout); else if (kind == 1) conv_compute<1>(a, l, pc0, tid, tin, tout); else conv_compute<2>(a, l, pc0, tid, tin, tout);
        __syncthreads();
        if (kind == 0) conv_store<0>(a, tt0, pc0, tid, tout); else if (kind == 1) conv_store<1>(a, tt0, pc0, tid, tout); else conv_store<2>(a, tt0, pc0, tid, tout);
        __syncthreads();
    }
    for (int u = launder_bid(); u < TOK / 32; u += gridDim.x) {
#pragma unroll 1
        for (int it = 0; it < 8; ++it) { const int item = it * NT + tid; const int t = u * 32 + (item >> 7), c8 = (item & 127) * 8; const int c = 1536 + c8;
            const uint4 w1 = *(const uint4*)(P + (size_t)t * NP + c);
            uint4 w0 = {0u, 0u, 0u, 0u}, w2 = {0u, 0u, 0u, 0u};
            if (!seq_first(t)) w0 = *(const uint4*)(P + (size_t)(t - 1) * NP + c);
            if (!seq_last(t)) w2 = *(const uint4*)(P + (size_t)(t + 1) * NP + c);
            const unsigned a0[4] = {w0.x, w0.y, w0.z, w0.w}, a1[4] = {w1.x, w1.y, w1.z, w1.w}, a2[4] = {w2.x, w2.y, w2.z, w2.w};
            float o[8];
#pragma unroll
            for (int e = 0; e < 8; ++e) { const int cc = c + e; const float p0 = (e & 1) ? bfhi(a0[e >> 1]) : bflo(a0[e >> 1]), p1 = (e & 1) ? bfhi(a1[e >> 1]) : bflo(a1[e >> 1]), p2 = (e & 1) ? bfhi(a2[e >> 1]) : bflo(a2[e >> 1]);
                float v = cb[cc] + cw[cc] * p0 + cw[3584 + cc] * p1 + cw[2 * 3584 + cc] * p2; o[e] = v / (1.0f + __expf(-v)); }
            uint4 w; w.x = pk2(o[0], o[1]); w.y = pk2(o[2], o[3]); w.z = pk2(o[4], o[5]); w.w = pk2(o[6], o[7]);
            *(uint4*)(QK + (size_t)t * 2048 + c8) = w; }
    }
}

__device__ __forceinline__ void gate_local_phase(const Args& a) {
    const int tid = launder_tid(), lane = tid & 63, wv = tid >> 6;
    const float* G = (const float*)(a.ws + WS_G);
    float* BJ = (float*)(a.ws + WS_BJ); float* PMJ = (float*)(a.ws + WS_PMJ); float* LOC = (float*)(a.ws + WS_LOC); bf16_t* WL = (bf16_t*)(a.ws + WS_WL); float2* BLML = (float2*)(a.ws + WS_BLML);
    for (int wt = launder_bid() * 8 + wv; wt < 8 * 384; wt += gridDim.x * 8) {
        const int dh = wt / 384, gc = wt % 384, dir = dh >> 2, head = dh & 3;
        const int t = dir ? gc * 64 + 63 - lane : gc * 64 + lane;
        const float ig = G[(size_t)t * 16 + dir * 8 + head], fg = G[(size_t)t * 16 + dir * 8 + 4 + head];
        const float lf = fminf(fg, 0.f) - log1pf(__expf(-fabsf(fg)));
        float b = lf;
#pragma unroll
        for (int o = 1; o < 64; o <<= 1) { const float t2 = my_shfl_up(b, o, lane); if (lane >= o) b += t2; }
        float pm = ig - b;
#pragma unroll
        for (int o = 1; o < 64; o <<= 1) { const float t2 = my_shfl_up(pm, o, lane); if (lane >= o) pm = fmaxf(pm, t2); }
        const float blast = my_shfl(b, 63), ml = wave_max(blast - b + ig);
        const size_t o1 = (size_t)dh * TOK + t;
        BJ[o1] = b; PMJ[o1] = pm; LOC[o1] = ig - b; WL[o1] = f2bf(__expf((ig - b) - (ml - blast)));
        if (lane == 0) BLML[dh * 384 + gc] = make_float2(blast, ml);
    }
}
__device__ __forceinline__ void sloc_phase(const Args& a) {
    const int tid = launder_tid(), lane = tid & 63, wv = tid >> 6, fr = lane & 15, fq = lane >> 4;
    const bf16_t* QK = (const bf16_t*)(a.ws + WS_QK); bf16_t* SL = (bf16_t*)(a.ws + WS_SL);
    const float* PMJ = (const float*)(a.ws + WS_PMJ); const float* LOC = (const float*)(a.ws + WS_LOC);
    for (int wt = launder_bid() * 8 + wv; wt < 8 * 384 * 4; wt += gridDim.x * 8) {
        const int rt = wt & 3, cg = wt >> 2, dh = cg / 384, gc = cg % 384, dir = dh >> 2, head = dh & 3, nb = gc * 64;
        const int jrow = rt * 16 + fr, tj = dir ? nb + 63 - jrow : nb + jrow;
        bf16x8 qf[8];
        { const bf16_t* qrow = QK + (size_t)tj * 2048 + head * 256 + fq * 8;
#pragma unroll
          for (int kk = 0; kk < 8; ++kk) qf[kk] = *(const bf16x8*)(qrow + kk * 32); }
        float pmr[4];
#pragma unroll
        for (int jj = 0; jj < 4; ++jj) { const int j = rt * 16 + fq * 4 + jj; pmr[jj] = PMJ[(size_t)dh * TOK + (dir ? nb + 63 - j : nb + j)]; }
#pragma unroll
        for (int ct = 0; ct < 4; ++ct) { f32x4 S = (f32x4){0.f, 0.f, 0.f, 0.f};
            const int sn = ct * 16 + fr; const bf16_t* krow = QK + (size_t)(nb + sn) * 2048 + 1024 + head * 256 + fq * 8;
#pragma unroll
            for (int kk = 0; kk < 8; ++kk) { const bf16x8 kf = *(const bf16x8*)(krow + kk * 32); S = __builtin_amdgcn_mfma_f32_16x16x32_bf16(qf[kk], kf, S, 0, 0, 0); }
            const float lc = LOC[(size_t)dh * TOK + nb + sn]; const int sd = dir ? 63 - sn : sn;
#pragma unroll
            for (int jj = 0; jj < 4; ++jj) { const int j = rt * 16 + fq * 4 + jj; const float v = (sd <= j) ? S[jj] * __expf(lc - pmr[jj]) : 0.f;
                SL[((size_t)dh * 384 + gc) * 4096 + j * 64 + sn] = f2bf(v); } }
    }
}

__device__ __forceinline__ void hf_phase(const Args& a, int l, unsigned char* lds) {
    const int tid = launder_tid(), lane = tid & 63, wv = tid >> 6, fr = lane & 15, fq = lane >> 4;
    const float* w3 = a.in[11] + (size_t)l * 64 * 2048;
    const float* H2T = (const float*)(a.ws + WS_H2T);
    for (int u = launder_bid(); u < 40 * 32; u += gridDim.x) {
        const int nt = u / 32, col0 = (u % 32) * 64;
        const int L = nt < 32 ? 16384 : 4096, n0 = (nt < 32 ? nt : nt - 32) * 512 + wv * 64;
        const float* hsrc = nt < 32 ? H2T : H2T + (size_t)64 * 16384;
        const int o = col0 >> 10, dir = (col0 >> 9) & 1, cb0 = col0 & 511;
        bf16_t* hf = (bf16_t*)(a.ws + (o ? WS_HF1 : WS_HF0)) + (nt < 32 ? 0 : HF_G1);
        float bw[4][16];
#pragma unroll
        for (int ctile = 0; ctile < 4; ++ctile)
#pragma unroll
            for (int kk = 0; kk < 16; ++kk) bw[ctile][kk] = w3[(size_t)(4 * kk + fq) * 2048 + col0 + ctile * 16 + fr];
#pragma unroll 1
        for (int ntile = 0; ntile < 4; ++ntile) {
            const int nb = n0 + ntile * 16;
            float aw[16];
#pragma unroll
            for (int kk = 0; kk < 16; ++kk) aw[kk] = hsrc[(size_t)(4 * kk + fq) * L + nb + fr];
            float tn[4];
#pragma unroll
            for (int jj = 0; jj < 4; ++jj) tn[jj] = (float)(nb + fq * 4 + jj) / (float)(L - 1);
#pragma unroll
            for (int ctile = 0; ctile < 4; ++ctile) { f32x4 acc = (f32x4){0.f, 0.f, 0.f, 0.f};
#pragma unroll
                for (int kk = 0; kk < 16; ++kk) acc = __builtin_amdgcn_mfma_f32_16x16x4f32(aw[kk], bw[ctile][kk], acc, 0, 0, 0);
                const int c = cb0 + ctile * 16 + fr; const float dl = fabsf(-3.0701134573253943f + (float)c * ((-15.350567286626972f + 3.0701134573253943f) / 511.0f));
                uint2 w; w.x = pk2(acc[0] * __expf(-tn[0] * dl), acc[1] * __expf(-tn[1] * dl)); w.y = pk2(acc[2] * __expf(-tn[2] * dl), acc[3] * __expf(-tn[3] * dl));
                *(uint2*)(hf + (size_t)(dir * 512 + c) * L + nb + fq * 4) = w; }
        }
    }
}

constexpr int S5_SEG = 128;
struct S5Dir { float ar, ai, asr, asi; bf16x8 bm[8]; bf16x8 cm[4]; };
__device__ __forceinline__ void s5_coef(const Args& a, int l, int dir, int g, int p, float& ar, float& ai, float& cr, float& ci, float& asr, float& asi) {
    const size_t o1 = (((size_t)l * 2 + dir) * 32 + g) * 64 + p;
    const float lr = fminf(a.in[13][o1], -1e-4f), li = a.in[14][o1];
    const float dt = expf(a.in[15][((size_t)l * 2 + dir) * 32 + g]);
    const float mag = expf(lr * dt); float sn, cs; sincosf(li * dt, &sn, &cs);
    ar = mag * cs; ai = mag * sn;
    const float mags = expf(lr * dt * (float)S5_SEG); sincosf(li * dt * (float)S5_SEG, &sn, &cs); asr = mags * cs; asi = mags * sn;
    const float nr = ar - 1.0f, ni = ai, den = 1.0f / (lr * lr + li * li);
    cr = (nr * lr + ni * li) * den; ci = (ni * lr - nr * li) * den;
}
__device__ __forceinline__ void s5_setup(const Args& a, int l, int dir, int g, int lane, bool need_c, S5Dir& q) {
    const int fr = lane & 15, fq = lane >> 4;
    float cr, ci; s5_coef(a, l, dir, g, lane, q.ar, q.ai, cr, ci, q.asr, q.asi);
    typedef unsigned u32x4_ __attribute__((ext_vector_type(4)));
#pragma unroll
    for (int ct = 0; ct < 8; ++ct) { const int pp = ct * 8 + (fr >> 1), part = fr & 1;
        const float pcr = my_shfl(cr, pp), pci = my_shfl(ci, pp);
        u32x4_ w = {0u, 0u, 0u, 0u};
        if (fq < 2) { const size_t ob = ((((size_t)l * 2 + dir) * 32 + g) * 64 + pp) * 16 + fq * 8; const float4 r0 = *(const float4*)(a.in[16] + ob), r1 = *(const float4*)(a.in[16] + ob + 4), i0 = *(const float4*)(a.in[17] + ob), i1 = *(const float4*)(a.in[17] + ob + 4);
            const float re[8] = {r0.x, r0.y, r0.z, r0.w, r1.x, r1.y, r1.z, r1.w}, im[8] = {i0.x, i0.y, i0.z, i0.w, i1.x, i1.y, i1.z, i1.w}; float v[8];
#pragma unroll
            for (int e = 0; e < 8; ++e) v[e] = part ? (pcr * im[e] + pci * re[e]) : (pcr * re[e] - pci * im[e]);
            w.x = pk2(v[0], v[1]); w.y = pk2(v[2], v[3]); w.z = pk2(v[4], v[5]); w.w = pk2(v[6], v[7]); }
        q.bm[ct] = __builtin_bit_cast(bf16x8, w); }
    if (need_c) {
        const float* cre = a.in[18] + ((((size_t)l * 2 + dir) * 32 + g) * 16 + fr) * 64; const float* cim = a.in[19] + ((((size_t)l * 2 + dir) * 32 + g) * 16 + fr) * 64;
#pragma unroll
        for (int kk = 0; kk < 4; ++kk) { const int p0 = kk * 16 + fq * 4; const float4 r = *(const float4*)(cre + p0), i = *(const float4*)(cim + p0);
            u32x4_ w; w.x = pk2(r.x, -i.x); w.y = pk2(r.y, -i.y); w.z = pk2(r.z, -i.z); w.w = pk2(r.w, -i.w); q.cm[kk] = __builtin_bit_cast(bf16x8, w); }
    }
}
__device__ __forceinline__ void s5_bu(const S5Dir& q, const float* us, float* buf, int bb, int fr, int fq) {
    typedef unsigned u32x4_ __attribute__((ext_vector_type(4)));
    u32x4_ w = {0u, 0u, 0u, 0u};
    if (fq < 2) { const float* ur = us + (bb * 16 + fr) * 16 + fq * 8; const float4 u0 = *(const float4*)ur, u1 = *(const float4*)(ur + 4); w.x = pk2(u0.x, u0.y); w.y = pk2(u0.z, u0.w); w.z = pk2(u1.x, u1.y); w.w = pk2(u1.z, u1.w); }
    const bf16x8 af = __builtin_bit_cast(bf16x8, w);
#pragma unroll
    for (int ct = 0; ct < 8; ++ct) { f32x4 acc = (f32x4){0.f, 0.f, 0.f, 0.f}; acc = __builtin_amdgcn_mfma_f32_16x16x32_bf16(af, q.bm[ct], acc, 0, 0, 0);
#pragma unroll
        for (int jj = 0; jj < 4; ++jj) buf[(fq * 4 + jj) * 132 + ct * 16 + fr] = acc[jj]; }
}
__device__ __forceinline__ void s5_stage_u(const bf16_t* P, int t0, int g, float* us, int lane) {
#pragma unroll
    for (int it = 0; it < 4; ++it) { const int item = it * 64 + lane, tt = item >> 1, hh = (item & 1) * 8;
        const uint4 w = *(const uint4*)(P + (size_t)(t0 + tt) * NP + 3584 + g * 16 + hh);
        float* d = us + tt * 16 + hh; *(float4*)d = make_float4(bflo(w.x), bfhi(w.x), bflo(w.y), bfhi(w.y)); *(float4*)(d + 4) = make_float4(bflo(w.z), bfhi(w.z), bflo(w.w), bfhi(w.w)); }
}
__device__ __forceinline__ void s5_l1_phase(const Args& a, int l, unsigned char* lds) {
    const int tid = launder_tid(), lane = tid & 63, wv = tid >> 6, fr = lane & 15, fq = lane >> 4;
    const bf16_t* P = (const bf16_t*)(a.ws + WS_P); float2* FIN = (float2*)(a.ws + WS_FIN);
    float* us = (float*)lds + wv * (S5_SEG * 16 + 16 * 132);
    float* buf = us + S5_SEG * 16;
    for (int bt = launder_bid(); bt < 768; bt += gridDim.x) {
        const int wt = bt * 8 + wv, sg = wt >> 5, g = wt & 31, t0 = sg * S5_SEG;
        __syncthreads();
        s5_stage_u(P, t0, g, us, lane);
        __syncthreads();
#pragma unroll 1
        for (int dir = 0; dir < 2; ++dir) {
            S5Dir q; s5_setup(a, l, dir, g, lane, false, q);
            float xr = 0.f, xi = 0.f;
#pragma unroll 1
            for (int b = 0; b < 8; ++b) { const int bb = dir ? 7 - b : b;
                s5_bu(q, us, buf, bb, fr, fq);
                __syncthreads();
#pragma unroll
                for (int s = 0; s < 16; ++s) { const int s16 = dir ? 15 - s : s; const float2 bu = *(const float2*)(buf + s16 * 132 + 2 * lane);
                    const float nr = q.ar * xr - q.ai * xi + bu.x, ni = q.ar * xi + q.ai * xr + bu.y; xr = nr; xi = ni; }
                __syncthreads();
            }
            FIN[(((size_t)sg * 2 + dir) * 32 + g) * 64 + lane] = make_float2(xr, xi);
        }
    }
    __syncthreads();
}
template <int DIR>
__device__ __forceinline__ void s5_l3_dir(const Args& a, int l, int sg, int g, int sfirst, int slast, const float* us, float* buf, f32x4 (&acc)[8], int lane, int fr, int fq) {
    const float2* FIN = (const float2*)(a.ws + WS_FIN);
    S5Dir q; s5_setup(a, l, DIR, g, lane, false, q);
    float cmf[32];
    { const float* cre = a.in[18] + ((((size_t)l * 2 + DIR) * 32 + g) * 16 + fr) * 64 + fq * 16; const float* cim = a.in[19] + ((((size_t)l * 2 + DIR) * 32 + g) * 16 + fr) * 64 + fq * 16;
#pragma unroll
      for (int pp = 0; pp < 16; ++pp) { cmf[2 * pp] = cre[pp]; cmf[2 * pp + 1] = -cim[pp]; } }
    float xr = 0.f, xi = 0.f;
    if (DIR == 0) { for (int j = sfirst; j < sg; ++j) { const float2 f = FIN[(((size_t)j * 2 + 0) * 32 + g) * 64 + lane]; const float nr = q.asr * xr - q.asi * xi + f.x, ni = q.asr * xi + q.asi * xr + f.y; xr = nr; xi = ni; } }
    else { for (int j = slast; j > sg; --j) { const float2 f = FIN[(((size_t)j * 2 + 1) * 32 + g) * 64 + lane]; const float nr = q.asr * xr - q.asi * xi + f.x, ni = q.asr * xi + q.asi * xr + f.y; xr = nr; xi = ni; } }
#pragma unroll
    for (int b = 0; b < 8; ++b) {
        const int bb = DIR ? 7 - b : b;
        s5_bu(q, us, buf, bb, fr, fq);
        __syncthreads();
#pragma unroll
        for (int s = 0; s < 16; ++s) { const int s16 = DIR ? 15 - s : s; float2* slot = (float2*)(buf + s16 * 132 + 2 * lane); const float2 bu = *slot;
            const float nr = q.ar * xr - q.ai * xi + bu.x, ni = q.ar * xi + q.ai * xr + bu.y; xr = nr; xi = ni; *slot = make_float2(xr, xi); }
        __syncthreads();
        { const float* xrow = buf + fr * 132 + fq * 32; f32x4 c = acc[bb];
#pragma unroll
          for (int k4 = 0; k4 < 8; ++k4) { const float4 xv = *(const float4*)(xrow + k4 * 4);
              c = __builtin_amdgcn_mfma_f32_16x16x4f32(xv.x, cmf[k4 * 4 + 0], c, 0, 0, 0); c = __builtin_amdgcn_mfma_f32_16x16x4f32(xv.y, cmf[k4 * 4 + 1], c, 0, 0, 0);
              c = __builtin_amdgcn_mfma_f32_16x16x4f32(xv.z, cmf[k4 * 4 + 2], c, 0, 0, 0); c = __builtin_amdgcn_mfma_f32_16x16x4f32(xv.w, cmf[k4 * 4 + 3], c, 0, 0, 0); }
          acc[bb] = c; }
        __syncthreads();
    }
}
__device__ __forceinline__ void s5_l3_task(const Args& a, int l, int bt, unsigned char* lds) {
    const int tid = launder_tid(), lane = tid & 63, wv = tid >> 6, fr = lane & 15, fq = lane >> 4;
    const bf16_t* P = (const bf16_t*)(a.ws + WS_P); bf16_t* Y = (bf16_t*)(a.ws + WS_S5Y);
    float* us = (float*)lds + wv * (S5_SEG * 16 + 16 * 132);
    float* buf = us + S5_SEG * 16;
    const int wt = bt * 8 + wv, sg = wt >> 5, g = wt & 31, t0 = sg * S5_SEG;
    const int sfirst = sg < 128 ? 0 : (sg < 160 ? 128 : 160), slast = sg < 128 ? 127 : (sg < 160 ? 159 : 191);
    __syncthreads();
    s5_stage_u(P, t0, g, us, lane);
    __syncthreads();
    f32x4 acc[8];
#pragma unroll
    for (int b = 0; b < 8; ++b) acc[b] = (f32x4){0.f, 0.f, 0.f, 0.f};
    s5_l3_dir<0>(a, l, sg, g, sfirst, slast, us, buf, acc, lane, fr, fq);
    s5_l3_dir<1>(a, l, sg, g, sfirst, slast, us, buf, acc, lane, fr, fq);
    const float dv = a.in[20][l * 512 + g * 16 + fr];
#pragma unroll
    for (int b = 0; b < 8; ++b)
#pragma unroll
        for (int j = 0; j < 4; ++j) { const int tt = b * 16 + fq * 4 + j; const float y = acc[b][j] + dv * us[tt * 16 + fr];
            const float inner = 0.7978845608028654f * (y + 0.044715f * y * y * y); const float gl = 0.5f * y * (1.0f + tanhf(inner));
            Y[(size_t)(t0 + tt) * 512 + g * 16 + fr] = f2bf(gl); }
}

typedef float f32x2 __attribute__((ext_vector_type(2)));
__device__ __forceinline__ f32x2 rot_mi(f32x2 v) { return (f32x2){v.y, -v.x}; }
__device__ __forceinline__ f32x2 rot_pi(f32x2 v) { return (f32x2){-v.y, v.x}; }
__device__ __forceinline__ f32x2 mul_w(f32x2 d, float c, float s) { return d * c + rot_mi(d) * s; }
__device__ __forceinline__ f32x2 mul_wc(f32x2 d, float c, float s) { return d * c + rot_pi(d) * s; }
template <int L> __device__ __forceinline__ void fft_dif(float2* Xf) {
    const int tid = launder_tid(); f32x2* X = (f32x2*)Xf;
#pragma unroll 1
    for (int q = L / 4; q >= 1; q >>= 2) {
        const float inv4 = 1.0f / (float)(4 * q);
#pragma unroll 2
        for (int i = tid; i < L / 4; i += NT) { const int k = i & (q - 1), j = ((i - k) << 2) + k;
            f32x2 x0, x1, x2, x3;
            if (q == 1) { const f32x4 lo = *(const f32x4*)(X + j), hi = *(const f32x4*)(X + j + 2); x0 = (f32x2){lo.x, lo.y}; x1 = (f32x2){lo.z, lo.w}; x2 = (f32x2){hi.x, hi.y}; x3 = (f32x2){hi.z, hi.w}; }
            else { x0 = X[j]; x1 = X[j + q]; x2 = X[j + 2 * q]; x3 = X[j + 3 * q]; }
            const float f4 = (float)k * inv4; const float c4 = cosr(f4), s4 = sinr(f4), c2 = cosr(2.0f * f4), s2 = sinr(2.0f * f4);
            const f32x2 y0 = x0 + x2, y1 = x1 + x3;
            const f32x2 y2 = mul_w(x0 - x2, c4, s4);
            const f32x2 y3 = rot_mi(mul_w(x1 - x3, c4, s4));
            const f32x2 z0 = y0 + y1, z2 = y2 + y3;
            const f32x2 z1 = mul_w(y0 - y1, c2, s2), z3 = mul_w(y2 - y3, c2, s2);
            if (q == 1) { *(f32x4*)(X + j) = (f32x4){z0.x, z0.y, z1.x, z1.y}; *(f32x4*)(X + j + 2) = (f32x4){z2.x, z2.y, z3.x, z3.y}; }
            else { X[j] = z0; X[j + q] = z1; X[j + 2 * q] = z2; X[j + 3 * q] = z3; } }
        __syncthreads();
    }
}
template <int L> __device__ __forceinline__ void fft_dit_inv(float2* Xf) {
    const int tid = launder_tid(); f32x2* X = (f32x2*)Xf;
#pragma unroll 1
    for (int q = 1; q <= L / 4; q <<= 2) {
        const float inv4 = 1.0f / (float)(4 * q);
#pragma unroll 2
        for (int i = tid; i < L / 4; i += NT) { const int k = i & (q - 1), j = ((i - k) << 2) + k;
            f32x2 z0, z1, z2, z3;
            if (q == 1) { const f32x4 lo = *(const f32x4*)(X + j), hi = *(const f32x4*)(X + j + 2); z0 = (f32x2){lo.x, lo.y}; z1 = (f32x2){lo.z, lo.w}; z2 = (f32x2){hi.x, hi.y}; z3 = (f32x2){hi.z, hi.w}; }
            else { z0 = X[j]; z1 = X[j + q]; z2 = X[j + 2 * q]; z3 = X[j + 3 * q]; }
            const float f4 = (float)k * inv4; const float c4 = cosr(f4), s4 = sinr(f4), c2 = cosr(2.0f * f4), s2 = sinr(2.0f * f4);
            const f32x2 b0 = mul_wc(z1, c2, s2), b1 = mul_wc(z3, c2, s2);
            const f32x2 y0 = z0 + b0, y1 = z0 - b0, y2 = z2 + b1, y3 = z2 - b1;
            const f32x2 g0 = mul_wc(y2, c4, s4);
            const f32x2 g1 = rot_pi(mul_wc(y3, c4, s4));
            const f32x2 x0 = y0 + g0, x2 = y0 - g0, x1 = y1 + g1, x3 = y1 - g1;
            if (q == 1) { *(f32x4*)(X + j) = (f32x4){x0.x, x0.y, x1.x, x1.y}; *(f32x4*)(X + j + 2) = (f32x4){x2.x, x2.y, x3.x, x3.y}; }
            else { X[j] = x0; X[j + q] = x1; X[j + 2 * q] = x2; X[j + 3 * q] = x3; } }
        __syncthreads();
    }
}
__device__ __forceinline__ f32x2 cmul(f32x2 a, f32x2 b) { return (f32x2){a.x * b.x - a.y * b.y, a.x * b.y + a.y * b.x}; }
__device__ __forceinline__ f32x2 cconj(f32x2 a) { return (f32x2){a.x, -a.y}; }
template <int L, int NSEQ>
__device__ __forceinline__ void hyena_task(const Args& a, int l, int c, unsigned char* lds) {
    constexpr int HP = L / 2 / NT;
    constexpr int LOGN = (L == 16384) ? 14 : 12;
    const int tid = launder_tid();
    f32x2* X = (f32x2*)lds;
    float* red = (float*)(lds + 131072);
    f32x2* SCR = (f32x2*)(a.ws + WS_SCR) + (size_t)launder_bid() * 16384;
    float* HYIN = (float*)(a.ws + WS_HYIN);
    const int tok0 = (L == 16384) ? 0 : 16384;
    f32x2 y[NSEQ][HP];
    float* zrow = HYIN + (size_t)c * TOK + tok0;
    __syncthreads();
#pragma unroll 1
    for (int o = 0; o < 2; ++o) {
        const bf16_t* hfw = (const bf16_t*)(a.ws + (o ? WS_HF1 : WS_HF0)) + (L == 16384 ? 0 : HF_G1) + (size_t)c * L;
        const bf16_t* hbw = (const bf16_t*)(a.ws + (o ? WS_HF1 : WS_HF0)) + (L == 16384 ? 0 : HF_G1) + (size_t)(512 + c) * L;
        float ssq = 0.f;
#pragma unroll 4
        for (int e = 0; e < 2 * HP; ++e) { const int n = tid + NT * e; const float Av = bf2f(hfw[n]); const float Bw = n >= 1 ? bf2f(hbw[n]) : 0.f; ssq += Av * Av + Bw * Bw; }
        ssq = wave_sum(ssq);
        if ((tid & 63) == 0) red[tid >> 6] = ssq;
        __syncthreads();
        float tot = 0.f;
#pragma unroll
        for (int w = 0; w < 8; ++w) tot += red[w];
        const float nrm = rsqrtf(tot + EPSN) * (1.0f / (float)L);
#pragma unroll 4
        for (int e = 0; e < 2 * HP; ++e) { const int n = tid + NT * e; f32x2 v;
            if (n < L / 2) { const unsigned w = *(const unsigned*)(hfw + 2 * n); v = (f32x2){bflo(w), bfhi(w)}; }
            else { const int m = 2 * n; v = (f32x2){m == L ? 0.f : bf2f(hbw[2 * L - m]), bf2f(hbw[2 * L - m - 1])}; }
            X[n] = v; }
        __syncthreads();
        fft_dif<L>((float2*)X);
#pragma unroll 4
        for (int e = 0; e < HP; ++e) { const int k = tid + NT * e;
            if (k == 0) { const f32x2 z0 = X[0]; SCR[0] = (f32x2){z0.x + z0.y, z0.x - z0.y}; }
            else { const int j = (int)(__brev((unsigned)k) >> (32 - LOGN)), jn = (int)(__brev((unsigned)(L - k)) >> (32 - LOGN));
                const f32x2 A = X[j], B = cconj(X[jn]); const f32x2 E = (A + B) * 0.5f, D = A - B; const f32x2 O = (f32x2){0.5f * D.y, -0.5f * D.x};
                const float fr = (float)k * (1.0f / (float)(2 * L)); const f32x2 wO = mul_w(O, cosr(fr), sinr(fr));
                SCR[k] = E + wO; SCR[L - k] = cconj(E - wO); } }
        if (tid == 0) SCR[L / 2] = cconj(X[1]);
#pragma unroll
        for (int s = 0; s < NSEQ; ++s) {
            __syncthreads();
#pragma unroll 4
            for (int e = 0; e < 2 * HP; ++e) { const int n = tid + NT * e; f32x2 v = (f32x2){0.f, 0.f}; if (n < L / 2) v = *(const f32x2*)(zrow + s * L + 2 * n); X[n] = v; }
            __syncthreads();
            fft_dif<L>((float2*)X);
#pragma unroll 4
            for (int e = 0; e < HP; ++e) { const int k = tid + NT * e;
                if (k == 0) { const f32x2 z0 = X[0], k0 = SCR[0]; const float y0 = (z0.x + z0.y) * k0.x, yn = (z0.x - z0.y) * k0.y; X[0] = (f32x2){0.5f * (y0 + yn), 0.5f * (y0 - yn)}; }
                else { const int j = (int)(__brev((unsigned)k) >> (32 - LOGN)), jn = (int)(__brev((unsigned)(L - k)) >> (32 - LOGN));
                    const f32x2 A = X[j], B = cconj(X[jn]); const f32x2 E = (A + B) * 0.5f, D = A - B; const f32x2 O = (f32x2){0.5f * D.y, -0.5f * D.x};
                    const float fr = (float)k * (1.0f / (float)(2 * L)); const float cw = cosr(fr), sw = sinr(fr); const f32x2 wO = mul_w(O, cw, sw);
                    const f32x2 Yk = cmul(E + wO, SCR[k]), Yn = cconj(cmul(cconj(E - wO), SCR[L - k]));
                    const f32x2 Ep = (Yk + Yn) * 0.5f, Op = mul_wc((Yk - Yn) * 0.5f, cw, sw);
                    X[j] = Ep + rot_pi(Op); X[jn] = cconj(Ep) + rot_pi(cconj(Op)); } }
            if (tid == 0) { const f32x2 A = X[1]; X[1] = cconj(cmul(cconj(A), SCR[L / 2])); }
            __syncthreads();
            fft_dit_inv<L>((float2*)X);
#pragma unroll
            for (int e = 0; e < HP; ++e) y[s][e] = X[tid + NT * e];
        }
        __syncthreads();
        const float sk = a.in[12][((size_t)l * 2 + o) * 512 + c];
#pragma unroll
        for (int s = 0; s < NSEQ; ++s)
#pragma unroll
            for (int e = 0; e < HP; ++e) { const int n = tid + NT * e; const f32x2 gt = *(const f32x2*)(HYIN + (size_t)((o + 1) * 512 + c) * TOK + tok0 + s * L + 2 * n); const f32x2 zo = *(const f32x2*)(zrow + s * L + 2 * n);
                *(f32x2*)(zrow + s * L + 2 * n) = gt * (y[s][e] * nrm + zo * sk); if ((e & 3) == 3) asm volatile("" ::: "memory"); }
    }
}

__device__ __forceinline__ bf16x8 scale_bf16x8(bf16x8 v, const float (&w)[8]) {
    typedef unsigned u32x4_ __attribute__((ext_vector_type(4)));
    const u32x4_ u = __builtin_bit_cast(u32x4_, v); u32x4_ r;
    r.x = pk2(bflo(u.x) * w[0], bfhi(u.x) * w[1]); r.y = pk2(bflo(u.y) * w[2], bfhi(u.y) * w[3]); r.z = pk2(bflo(u.z) * w[4], bfhi(u.z) * w[5]); r.w = pk2(bflo(u.w) * w[6], bfhi(u.w) * w[7]);
    return __builtin_bit_cast(bf16x8, r);
}
constexpr int ML_NVT = 4, ML_VB = ML_NVT * 16, ML_ROWS = (ML_NVT + 1) * 16, ML_NVS = 256 / ML_VB;
struct MlCtx { const bf16_t* QK; const bf16_t* SL; const bf16_t* KT; const bf16_t* VT; const float* BJ; const float* PMJ; const bf16_t* WL; const float2* BLML; bf16_t* MLH; bf16_t* CTb0; bf16_t* VST;
               int dir, tok0, L, head, vs, dh, lane, fr, fq, rw; };
struct MlOutSet { bf16x8 qf[8], sf[2], vf[ML_NVT][2]; float pmv, bjv; float2 bm; };
struct MlUpdSet { bf16x8 kf[4][2], lc[2]; float2 bm; };
__device__ __forceinline__ int ml_nb(const MlCtx& x, int cc) { return x.dir ? x.tok0 + x.L - 64 * (cc + 1) : x.tok0 + 64 * cc; }
__device__ __forceinline__ void ml_load_out(const MlCtx& x, MlOutSet& s, int cc) {
    const int nb = ml_nb(x, cc), gc = nb >> 6, jrow = x.rw * 16 + x.fr, tj = x.dir ? nb + 63 - jrow : nb + jrow; const bf16_t* qrow = x.QK + (tj * 2048 + x.head * 256 + x.fq * 8);
#pragma unroll
    for (int kk = 0; kk < 8; ++kk) s.qf[kk] = *(const bf16x8*)(qrow + kk * 32);
    const bf16_t* srow = x.SL + ((x.dh * 384 + gc) * 4096 + jrow * 64 + x.fq * 8); s.sf[0] = *(const bf16x8*)(srow); s.sf[1] = *(const bf16x8*)(srow + 32);
#pragma unroll
    for (int vt = 0; vt < ML_NVT; ++vt) { const bf16_t* vrow = x.VT + ((vt * 16 + x.fr) * TOK + nb + x.fq * 8); s.vf[vt][0] = *(const bf16x8*)(vrow); s.vf[vt][1] = *(const bf16x8*)(vrow + 32); }
    s.pmv = x.PMJ[tj]; s.bjv = x.BJ[tj];
    s.bm = x.BLML[gc];
}
__device__ __forceinline__ void ml_load_upd(const MlCtx& x, MlUpdSet& s, int cc) {
    const int nb = ml_nb(x, cc);
#pragma unroll
    for (int di = 0; di < 4; ++di) { const bf16_t* krow = x.KT + (((x.rw * 4 + di) * 16 + x.fr) * TOK + nb + x.fq * 8); s.kf[di][0] = *(const bf16x8*)(krow); s.kf[di][1] = *(const bf16x8*)(krow + 32); }
#pragma unroll
    for (int kk = 0; kk < 2; ++kk) s.lc[kk] = *(const bf16x8*)(x.WL + nb + kk * 32 + x.fq * 8);
    s.bm = x.BLML[nb >> 6];
}
#define ML_BAR() do { asm volatile("s_waitcnt lgkmcnt(0)" ::: "memory"); __builtin_amdgcn_s_barrier(); asm volatile("" ::: "memory"); } while (0)
__device__ __forceinline__ void ml_publish_v(const MlCtx& x, const MlOutSet& s, int cc) {
    bf16_t* dst = x.VST + (cc & 1) * (ML_NVT * 1024) + x.lane * 8;
#pragma unroll
    for (int vt = 0; vt < ML_NVT; ++vt) { *(bf16x8*)(dst + vt * 1024) = s.vf[vt][0]; *(bf16x8*)(dst + vt * 1024 + 512) = s.vf[vt][1]; }
}
__device__ __forceinline__ void ml_out_step(const MlCtx& x, MlOutSet& s, const MlOutSet& sn, int c, int nchunk, float& m) {
    const int nb = ml_nb(x, c);
    const bf16_t* CTb = x.CTb0 + (c & 1) * (ML_ROWS * 264);
    const int jrow = x.rw * 16 + x.fr, tj = x.dir ? nb + 63 - jrow : nb + jrow;
    const float mx = fmaxf(m, s.pmv); float inter = __expf(m - mx), rsc = __expf(s.pmv - mx); const float emt = __expf(-s.bjv - mx);
    const float mnew = fmaxf(s.bm.x + m, s.bm.y);
    bf16x8 bA[8];
    { const bf16_t* crow = CTb + (ML_NVT * 16 + x.fr) * 264 + x.fq * 8;
#pragma unroll
      for (int kk = 0; kk < 8; ++kk) bA[kk] = *(const bf16x8*)(crow + kk * 32);
      f32x4 Oc = (f32x4){0.f, 0.f, 0.f, 0.f}, Os = (f32x4){0.f, 0.f, 0.f, 0.f};
#pragma unroll
      for (int kk = 0; kk < 8; ++kk) Oc = __builtin_amdgcn_mfma_f32_16x16x32_bf16(bA[kk], s.qf[kk], Oc, 0, 0, 0);
      const short one = (x.fr == 0) ? (short)0x3F80 : (short)0; const bf16x8 ones = {one, one, one, one, one, one, one, one};
#pragma unroll
      for (int kk = 0; kk < 2; ++kk) Os = __builtin_amdgcn_mfma_f32_16x16x32_bf16(ones, s.sf[kk], Os, 0, 0, 0);
      float den = inter * Oc[0] + rsc * Os[0]; den = my_shfl(den, x.lane & 15);
      const float dnv = 1.0f / fmaxf(fabsf(den), emt); inter *= dnv; rsc *= dnv; }
#pragma unroll
    for (int ct = 0; ct < ML_NVT; ++ct) {
        __builtin_amdgcn_sched_barrier(0);
        { const bf16_t* crow = CTb + (ct * 16 + x.fr) * 264 + x.fq * 8;
#pragma unroll
          for (int kk = 0; kk < 8; ++kk) bA[kk] = *(const bf16x8*)(crow + kk * 32); }
        __builtin_amdgcn_sched_barrier(0);
        f32x4 Oc = (f32x4){0.f, 0.f, 0.f, 0.f}, Os = (f32x4){0.f, 0.f, 0.f, 0.f};
#pragma unroll
        for (int kk = 0; kk < 8; ++kk) Oc = __builtin_amdgcn_mfma_f32_16x16x32_bf16(bA[kk], s.qf[kk], Oc, 0, 0, 0);
#pragma unroll
        for (int kk = 0; kk < 2; ++kk) Os = __builtin_amdgcn_mfma_f32_16x16x32_bf16(s.vf[ct][kk], s.sf[kk], Os, 0, 0, 0);
        uint2 w_; w_.x = pk2(inter * Oc[0] + rsc * Os[0], inter * Oc[1] + rsc * Os[1]); w_.y = pk2(inter * Oc[2] + rsc * Os[2], inter * Oc[3] + rsc * Os[3]);
        *(uint2*)(x.MLH + (tj * 1024 + x.head * 256 + x.vs * ML_VB + ct * 16 + x.fq * 4)) = w_; }
    __builtin_amdgcn_sched_barrier(0);
    if (c + 2 < nchunk) ml_load_out(x, s, c + 2);
    __builtin_amdgcn_sched_barrier(0);
    m = mnew;
    if (c + 1 < nchunk) ml_publish_v(x, sn, c + 1);
    ML_BAR();
}
__device__ __forceinline__ void ml_upd_step(const MlCtx& x, MlUpdSet& s, f32x4 (&CT)[ML_NVT + 1][4], int c, int nchunk, float& m) {
    bf16_t* CTn = x.CTb0 + ((c + 1) & 1) * (ML_ROWS * 264);
    const float mnew = fmaxf(s.bm.x + m, s.bm.y), decay = __expf(s.bm.x + m - mnew), wsc = __expf(s.bm.y - mnew);
    bf16x8 an[2], vf[ML_NVT][2];
    { const bf16_t* src = x.VST + (c & 1) * (ML_NVT * 1024) + x.lane * 8;
#pragma unroll
      for (int vt = 0; vt < ML_NVT; ++vt) { vf[vt][0] = *(const bf16x8*)(src + vt * 1024); vf[vt][1] = *(const bf16x8*)(src + vt * 1024 + 512); } }
#pragma unroll
    for (int kk = 0; kk < 2; ++kk) { typedef unsigned u32x4_ __attribute__((ext_vector_type(4))); const u32x4_ lw = __builtin_bit_cast(u32x4_, s.lc[kk]);
        const float w8[8] = {bflo(lw.x) * wsc, bfhi(lw.x) * wsc, bflo(lw.y) * wsc, bfhi(lw.y) * wsc, bflo(lw.z) * wsc, bfhi(lw.z) * wsc, bflo(lw.w) * wsc, bfhi(lw.w) * wsc};
#pragma unroll
        for (int di = 0; di < 4; ++di) s.kf[di][kk] = scale_bf16x8(s.kf[di][kk], w8);
        const short one = (x.fr == 0) ? (short)0x3F80 : (short)0; an[kk] = (bf16x8){one, one, one, one, one, one, one, one}; }
#pragma unroll
    for (int vt = 0; vt < ML_NVT + 1; ++vt)
#pragma unroll
        for (int di = 0; di < 4; ++di) { f32x4 cacc = CT[vt][di] * decay;
            cacc = __builtin_amdgcn_mfma_f32_16x16x32_bf16(s.kf[di][0], vt < ML_NVT ? vf[vt < ML_NVT ? vt : 0][0] : an[0], cacc, 0, 0, 0); cacc = __builtin_amdgcn_mfma_f32_16x16x32_bf16(s.kf[di][1], vt < ML_NVT ? vf[vt < ML_NVT ? vt : 0][1] : an[1], cacc, 0, 0, 0);
            CT[vt][di] = cacc; }
    __builtin_amdgcn_sched_barrier(0);
    if (c + 2 < nchunk) ml_load_upd(x, s, c + 2);
    __builtin_amdgcn_sched_barrier(0);
#pragma unroll
    for (int vt = 0; vt < ML_NVT + 1; ++vt)
#pragma unroll
        for (int di = 0; di < 4; ++di)
            { uint2 w_; w_.x = pk2(CT[vt][di][0], CT[vt][di][1]); w_.y = pk2(CT[vt][di][2], CT[vt][di][3]); *(uint2*)(CTn + (vt * 16 + x.fr) * 264 + (x.rw * 4 + di) * 16 + x.fq * 4) = w_; }
    m = mnew;
    ML_BAR();
}
__device__ __forceinline__ void mlstm_task(const Args& a, int task, unsigned char* lds) {
    const int tid = launder_tid(), lane = tid & 63, wv = tid >> 6;
    int seq, rem; if (task < 8 * ML_NVS) { seq = 0; rem = task; } else { seq = 1 + (task - 8 * ML_NVS) / (8 * ML_NVS); rem = (task - 8 * ML_NVS) % (8 * ML_NVS); }
    MlCtx x;
    x.vs = rem % ML_NVS; x.dir = (rem / ML_NVS) & 1; x.head = rem / (2 * ML_NVS); x.dh = x.dir * 4 + x.head; x.lane = lane; x.fr = lane & 15; x.fq = lane >> 4; x.rw = wv & 3;
    x.L = seq == 0 ? 16384 : 4096; x.tok0 = seq == 0 ? 0 : 16384 + (seq - 1) * 4096; const int nchunk = x.L / 64;
    x.QK = (const bf16_t*)(a.ws + WS_QK); x.SL = (const bf16_t*)(a.ws + WS_SL);
    x.KT = (const bf16_t*)(a.ws + WS_KT) + (size_t)x.head * 256 * TOK; x.VT = (const bf16_t*)(a.ws + WS_VT) + (size_t)(x.head * 256 + x.vs * ML_VB) * TOK;
    x.BJ = (const float*)(a.ws + WS_BJ) + (size_t)x.dh * TOK; x.PMJ = (const float*)(a.ws + WS_PMJ) + (size_t)x.dh * TOK; x.WL = (const bf16_t*)(a.ws + WS_WL) + (size_t)x.dh * TOK;
    x.BLML = (const float2*)(a.ws + WS_BLML) + x.dh * 384;
    x.MLH = (bf16_t*)(a.ws + WS_MLH) + (size_t)x.dir * TOK * 1024;
    x.VST = (bf16_t*)(lds + 2 * ML_ROWS * 264 * 2);
    x.CTb0 = (bf16_t*)lds;
    __syncthreads();
    for (int i = tid; i < ML_ROWS * 264; i += NT) x.CTb0[i] = 0;
    __syncthreads();
    float m = 0.f;
    if (wv < 4) {
        MlOutSet s0, s1;
        ml_load_out(x, s0, 0); ml_load_out(x, s1, 1);
        ml_publish_v(x, s0, 0); ML_BAR();
#pragma unroll 1
        for (int c = 0; c < nchunk; c += 4) { ml_out_step(x, s0, s1, c, nchunk, m); ml_out_step(x, s1, s0, c + 1, nchunk, m); ml_out_step(x, s0, s1, c + 2, nchunk, m); ml_out_step(x, s1, s0, c + 3, nchunk, m); }
    } else {
        f32x4 CT[ML_NVT + 1][4];
#pragma unroll
        for (int i = 0; i < ML_NVT + 1; ++i)
#pragma unroll
            for (int j = 0; j < 4; ++j) CT[i][j] = (f32x4){0.f, 0.f, 0.f, 0.f};
        MlUpdSet s0, s1;
        ml_load_upd(x, s0, 0); ml_load_upd(x, s1, 1);
        ML_BAR();
#pragma unroll 1
        for (int c = 0; c < nchunk; c += 4) { ml_upd_step(x, s0, CT, c, nchunk, m); ml_upd_step(x, s1, CT, c + 1, nchunk, m); ml_upd_step(x, s0, CT, c + 2, nchunk, m); ml_upd_step(x, s1, CT, c + 3, nchunk, m); }
    }
    __syncthreads();
}
#undef ML_BAR

__device__ __forceinline__ void groupnorm_phase(const Args& a, int l, unsigned char* lds) {
    const int tid = launder_tid(), tt = tid >> 4, sub = tid & 15;
    const float* gn = a.in[24] + (size_t)l * 2048;
    const float* HYIN = (const float*)(a.ws + WS_HYIN); const float* S5O = (const float*)(a.ws + WS_S5O); const bf16_t* MLH = (const bf16_t*)(a.ws + WS_MLH);
    const bf16_t* P = (const bf16_t*)(a.ws + WS_P); bf16_t* MIX = (bf16_t*)(a.ws + WS_MIX);
    float* hy = (float*)lds;
    for (int u = launder_bid(); u < TOK / 32; u += gridDim.x) {
        const int t0 = u * 32, t = t0 + tt;
        __syncthreads();
#pragma unroll
        for (int it = 0; it < 8; ++it) { const int c = (tid >> 3) + 64 * it, sg = (tid & 7) * 4; const float4 v = *(const float4*)(HYIN + (size_t)c * TOK + t0 + sg);
            float* d = hy + c * 33 + sg; d[0] = v.x; d[1] = v.y; d[2] = v.z; d[3] = v.w; }
        __syncthreads();
        { float ss = 0.f;
#pragma unroll
          for (int i = 0; i < 32; ++i) { const float v = hy[(sub + 16 * i) * 33 + tt]; ss += v * v; }
          ss += shflx(ss, 1, tid & 63); ss += shflx(ss, 2, tid & 63); ss += shflx(ss, 4, tid & 63); ss += shflx(ss, 8, tid & 63);
          const float rs = rsqrtf(ss * (1.0f / 512.0f) + EPSN);
#pragma unroll
          for (int i = 0; i < 4; ++i) { const int c0 = sub * 8 + 128 * i; float o[8];
#pragma unroll
              for (int e = 0; e < 8; ++e) o[e] = hy[(c0 + e) * 33 + tt] * rs * gn[c0 + e];
              uint4 w; w.x = pk2(o[0], o[1]); w.y = pk2(o[2], o[3]); w.z = pk2(o[4], o[5]); w.w = pk2(o[6], o[7]);
              *(uint4*)(MIX + (size_t)t * 2048 + c0) = w; } }
        { float4 v[8]; float ss = 0.f;
#pragma unroll
          for (int i = 0; i < 8; ++i) { v[i] = *(const float4*)(S5O + (size_t)t * 512 + i * 64 + sub * 4); ss += v[i].x * v[i].x + v[i].y * v[i].y + v[i].z * v[i].z + v[i].w * v[i].w; }
          ss += shflx(ss, 1, tid & 63); ss += shflx(ss, 2, tid & 63); ss += shflx(ss, 4, tid & 63); ss += shflx(ss, 8, tid & 63);
          const float rs = rsqrtf(ss * (1.0f / 512.0f) + EPSN);
#pragma unroll
          for (int i = 0; i < 8; ++i) { const int c0 = i * 64 + sub * 4; const float4 g = *(const float4*)(gn + 512 + c0);
              uint2 w; w.x = pk2(v[i].x * rs * g.x, v[i].y * rs * g.y); w.y = pk2(v[i].z * rs * g.z, v[i].w * rs * g.w); *(uint2*)(MIX + (size_t)t * 2048 + 512 + c0) = w; } }
#pragma unroll 1
        for (int hd = 0; hd < 4; ++hd) { float hv[16]; float ss = 0.f;
#pragma unroll
            for (int i = 0; i < 2; ++i) { const int c0 = hd * 256 + sub * 8 + 128 * i; const uint4 wf = *(const uint4*)(MLH + (size_t)t * 1024 + c0), wb = *(const uint4*)(MLH + (size_t)TOK * 1024 + (size_t)t * 1024 + c0);
                hv[i * 8 + 0] = bflo(wf.x) + bflo(wb.x); hv[i * 8 + 1] = bfhi(wf.x) + bfhi(wb.x); hv[i * 8 + 2] = bflo(wf.y) + bflo(wb.y); hv[i * 8 + 3] = bfhi(wf.y) + bfhi(wb.y);
                hv[i * 8 + 4] = bflo(wf.z) + bflo(wb.z); hv[i * 8 + 5] = bfhi(wf.z) + bfhi(wb.z); hv[i * 8 + 6] = bflo(wf.w) + bflo(wb.w); hv[i * 8 + 7] = bfhi(wf.w) + bfhi(wb.w); }
#pragma unroll
            for (int e = 0; e < 16; ++e) ss += hv[e] * hv[e];
            ss += shflx(ss, 1, tid & 63); ss += shflx(ss, 2, tid & 63); ss += shflx(ss, 4, tid & 63); ss += shflx(ss, 8, tid & 63);
            const float rs = rsqrtf(ss * (1.0f / 256.0f) + EPSN);
#pragma unroll
            for (int i = 0; i < 2; ++i) { const int c0 = hd * 256 + sub * 8 + 128 * i; const uint4 wo = *(const uint4*)(P + (size_t)t * NP + 5120 + c0);
                const float og[8] = {bflo(wo.x), bfhi(wo.x), bflo(wo.y), bfhi(wo.y), bflo(wo.z), bfhi(wo.z), bflo(wo.w), bfhi(wo.w)}; float o[8];
#pragma unroll
                for (int e = 0; e < 8; ++e) o[e] = hv[i * 8 + e] * rs * gn[1024 + c0 + e] * sigmoidf_(og[e]);
                uint4 w; w.x = pk2(o[0], o[1]); w.y = pk2(o[2], o[3]); w.z = pk2(o[4], o[5]); w.w = pk2(o[6], o[7]);
                *(uint4*)(MIX + (size_t)t * 2048 + 1024 + c0) = w; } }
    }
    __syncthreads();
}

constexpr int NTASK_ML = 24 * ML_NVS, NTASK_HY0 = 512, NTASK_HY1 = 512, NTASK_S5 = 768, NTASK_CV = CVT_ALL - CVT_EARLY, NTASK_MIX = NTASK_ML + NTASK_HY0 + NTASK_HY1 + NTASK_S5, NTASK_D = NTASK_MIX + NTASK_CV + CVT_WIN;
__device__ __forceinline__ void mixers_phase(const Args& a, int l, unsigned char* lds, int coff, int mask = 15) {
    unsigned* ctr = (unsigned*)(a.ws + WS_CTR) + l * 64 + coff;
    volatile int* slot = (volatile int*)(lds + LDS_BYTES - 64);
    for (;;) {
        __syncthreads();
        if (launder_tid() == 0) *slot = (int)atomicAdd(ctr, 1u);
        __syncthreads();
        int task = *slot;
        if (task >= NTASK_D + (PROBE == 21 ? NTASK_S5 : 0)) break;
        if (PROBE == 21 && task >= NTASK_D) task -= NTASK_S5 + NTASK_CV + CVT_WIN;
        const int cls = task < NTASK_ML ? 1 : (task < NTASK_ML + NTASK_HY0 + NTASK_HY1 ? 2 : (task < NTASK_MIX ? 4 : 8));
        if (!(mask & cls)) continue;
        if (task < NTASK_ML) mlstm_task(a, task, lds);
        else if (task < NTASK_ML + NTASK_HY0) hyena_task<16384, 1>(a, l, task - NTASK_ML, lds);
        else if (task < NTASK_ML + NTASK_HY0 + NTASK_HY1) hyena_task<4096, 2>(a, l, task - NTASK_ML - NTASK_HY0, lds);
        else if (task < NTASK_MIX) s5_l3_task(a, l, task - (NTASK_ML + NTASK_HY0 + NTASK_HY1), lds);
        else if (task < NTASK_MIX + NTASK_CV) { __syncthreads(); convert_tile(a, l, CVT_EARLY + (task - NTASK_MIX), (float*)lds); }
        else if (l + 1 < NLAYER) { __syncthreads(); convert_tile(a, l + 1, task - NTASK_MIX - NTASK_CV, (float*)lds); }
    }
    __syncthreads();
}

#define LAS __attribute__((address_space(3)))

#define XB_TMO      128
#define XB_XCNT(j)  (256  + 64 * (j))
#define XB_XSUB(j)  (1280 + 64 * (j))
#define XB_XGEN(j)  (2304 + 64 * (j))
#define XB_TOP      3328
#define XB_TOPGEN   3392
#define XCD_BAR_WORDS 3456
#define XB_SPIN_CAP (1u << 18)

__device__ __forceinline__ unsigned xb_ld(unsigned* p)              { return __hip_atomic_load(p, __ATOMIC_RELAXED, __HIP_MEMORY_SCOPE_AGENT); }
__device__ __forceinline__ unsigned xb_add(unsigned* p, unsigned v) { return __hip_atomic_fetch_add(p, v, __ATOMIC_RELAXED, __HIP_MEMORY_SCOPE_AGENT); }
__device__ __forceinline__ unsigned xb_xcc_id() { return (unsigned)__builtin_amdgcn_s_getreg((3 << 11) | 20) & 0xFu; }
#define XB_SPIN(cond, bar) do { unsigned _sp = 0; while (cond) { __builtin_amdgcn_s_sleep(1); \
    if ((++_sp & 255u) == 0u) { if (xb_ld(&(bar)[XB_TMO])) break; if (_sp > XB_SPIN_CAP) { atomicAdd(&(bar)[XB_TMO], 1u); break; } } } } while (0)

struct XcdBarrier {
    unsigned* bar; unsigned x;
    volatile LAS unsigned* st;
};

__device__ __forceinline__ XcdBarrier xcd_barrier_post(unsigned* bar, volatile LAS unsigned* st) {
    XcdBarrier b; b.bar = bar; b.x = xb_xcc_id(); b.st = st;
    if (threadIdx.x == 0) (void)xb_add(&bar[XB_XCNT(b.x)], 1u);
    return b;
}
__device__ __forceinline__ void xcd_barrier_complete(unsigned* bar, unsigned x, unsigned& nloc, unsigned& nx) {
    const unsigned G = gridDim.x * gridDim.y * gridDim.z;
    unsigned sum, cnt, mine, sp = 0u;
    for (;;) {
        sum = 0u; cnt = 0u; mine = 0u;
#pragma unroll
        for (unsigned j = 0; j < 16; ++j) { const unsigned c = xb_ld(&bar[XB_XCNT(j)]); sum += c; cnt += (c > 0u) ? 1u : 0u; mine = (j == x) ? c : mine; }
        if (sum == G) break;
        __builtin_amdgcn_s_sleep(1);
        if ((++sp & 255u) == 0u) { if (xb_ld(&bar[XB_TMO])) break; if (sp > XB_SPIN_CAP) { atomicAdd(&bar[XB_TMO], 1u); break; } }
    }
    nloc = mine > 0u ? mine : 1u; nx = cnt > 0u ? cnt : 1u;
}

__device__ __forceinline__ void xcd_barrier(const XcdBarrier& b) {
    asm volatile("s_waitcnt vmcnt(0)" ::: "memory");
    __syncthreads();
    if (threadIdx.x == 0) {
        unsigned* bar = b.bar;
        __builtin_amdgcn_s_waitcnt(0);
        unsigned nloc = b.st[0], nx = b.st[1];
        if (nloc == 0u) { xcd_barrier_complete(bar, b.x, nloc, nx); b.st[0] = nloc; b.st[1] = nx; }
        const unsigned old = xb_add(&bar[XB_XSUB(b.x)], 1u);
        const unsigned gen = old / nloc;
        if (old + 1u == (gen + 1u) * nloc) {
            __builtin_amdgcn_fence(__ATOMIC_RELEASE, "agent");
            asm volatile("s_waitcnt vmcnt(0)" ::: "memory");
            const unsigned og = xb_add(&bar[XB_TOP], 1u);
            const unsigned tg = og / nx;
            if (og + 1u == (tg + 1u) * nx) xb_add(&bar[XB_TOPGEN], 1u);
            else XB_SPIN(xb_ld(&bar[XB_TOPGEN]) == tg, bar);
            __builtin_amdgcn_fence(__ATOMIC_ACQUIRE, "agent");
            xb_add(&bar[XB_XGEN(b.x)], 1u);
            asm volatile("s_waitcnt vmcnt(0)" ::: "memory");
        } else {
            XB_SPIN(xb_ld(&bar[XB_XGEN(b.x)]) == gen, bar);
            __builtin_amdgcn_fence(__ATOMIC_ACQUIRE, "agent");
            asm volatile("s_waitcnt vmcnt(0)" ::: "memory");
        }
    }
    __syncthreads();
}


__device__ __forceinline__ Args load_args() {
#if defined(__HIP_DEVICE_COMPILE__)
    unsigned long long p = (unsigned long long)__builtin_amdgcn_kernarg_segment_ptr();
    asm volatile("" : "+s"(p));
    return *(const __attribute__((address_space(4))) Args*)p;
#else
    return Args{};
#endif
}
#ifndef PROBE
#define PROBE 0
#endif
#define GREP(body) do { _Pragma("unroll 1") for (int rep_ = 0; rep_ < (PROBE == 1 ? 2 : 1); ++rep_) { body } } while (0)
constexpr int PH_PER_LAYER = 11, PH_TOTAL = NLAYER * PH_PER_LAYER + 1;
__global__ void __launch_bounds__(NT, 2) mk_fwd(Args a_in) {
    extern __shared__ __attribute__((aligned(16))) unsigned char lds[];
    cg::grid_group grid = cg::this_grid();
    PG8_LAS unsigned char* gl = (PG8_LAS unsigned char*)lds;
    const int lo = a_in.ph_lo, hi = a_in.ph_hi;
    const int G = (int)gridDim.x, bx = (int)blockIdx.x;
    volatile LAS unsigned* xst = (volatile LAS unsigned*)((PG8_LAS unsigned char*)lds + (LDS_BYTES - 32));
    if (threadIdx.x < 2) xst[threadIdx.x] = 0u;
    __syncthreads();
    const XcdBarrier xbar = xcd_barrier_post((unsigned*)(a_in.ws + WS_CTR + 4096), xst);
#define RUN(id) ((id) >= lo && (id) < hi)
#define SEAM(id) do { if ((id) >= lo && (id) + 1 < hi) { if ((id) == 0) grid.sync(); else xcd_barrier(xbar); } } while (0)
#pragma unroll 1
    for (int l = 0; l < NLAYER; ++l) {
        const int b = l * PH_PER_LAYER;
        if (RUN(b + 0)) { const Args a = load_args(); unsigned char* wb = a.ws + WS_WB; (void)wb; if (l == 0) rows_phase<0>(a, 0, lds); else rows_phase<2>(a, l - 1, lds); convert_weights(a, l, lds); h2_phase(a, l); }
        SEAM(b + 0);
        if (RUN(b + 1)) { const Args a = load_args(); unsigned char* wb = a.ws + WS_WB; (void)wb; pg8::Gemm g{(const bf16_t*)(a.ws + WS_H), (const bf16_t*)(wb + WB_WIN), TOK, NP, DM}; pg8::StaticOrder S; S.init(TOK, NP, G, launder_bid());
            pg8::EpiBf16X<0> E{(bf16_t*)(a.ws + WS_P), NP}; GREP(pg8::gemm_phase(gl, g, S, E);); }
        SEAM(b + 1);
#if PROBE == 2
        if (RUN(b + 2)) { const Args a = load_args(); gate_local_phase(a); conv_phase(a, l, lds); s5_l1_phase(a, l, lds); grid.sync(); sloc_phase(a); hf_phase(a, l, lds); grid.sync(); mixers_phase(a, l, lds, 16); grid.sync(); }
#endif
#if PROBE == 5 || PROBE == 7
        if (RUN(b + 2)) { const Args a = load_args(); unsigned char* wb = a.ws + WS_WB; (void)wb; gate_local_phase(a); conv_phase(a, l, lds); s5_l1_phase(a, l, lds); grid.sync(); sloc_phase(a); hf_phase(a, l, lds); grid.sync();
#if PROBE == 5
            mixers_phase(a, l, lds, 16, 2); grid.sync();
#endif
        }
#endif
        if (RUN(b + 2)) { const Args a = load_args(); unsigned char* wb = a.ws + WS_WB; (void)wb; gate_local_phase(a); conv_phase(a, l, lds); s5_l1_phase(a, l, lds);
#if PROBE == 10
            conv_phase(a, l, lds);
#elif PROBE == 12
            s5_l1_phase(a, l, lds);
#elif PROBE == 14
            gate_local_phase(a);
#endif
        }
        SEAM(b + 2);
        if (RUN(b + 3)) { const Args a = load_args(); unsigned char* wb = a.ws + WS_WB; (void)wb; sloc_phase(a); hf_phase(a, l, lds);
#if PROBE == 11
            hf_phase(a, l, lds);
#elif PROBE == 13
            sloc_phase(a);
#endif
        }
        SEAM(b + 3);
        if (RUN(b + 4)) { const Args a = load_args(); mixers_phase(a, l, lds, 0); }
        SEAM(b + 4);
        if (RUN(b + 5)) { const Args a = load_args(); unsigned char* wb = a.ws + WS_WB; (void)wb; pg8::Gemm g{(const bf16_t*)(a.ws + WS_S5Y), (const bf16_t*)(wb + WB_GLU), TOK, 1024, 512}; pg8::StaticOrder S; S.init(TOK, 1024, G, launder_bid());
            pg8::EpiGlu E{(float*)(a.ws + WS_S5O), 512, a.in[22] + l * 1024}; GREP(pg8::gemm_phase(gl, g, S, E);); }
        SEAM(b + 5);
        if (RUN(b + 6)) { const Args a = load_args(); groupnorm_phase(a, l, lds); }
        SEAM(b + 6);
        if (RUN(b + 7)) { const Args a = load_args(); unsigned char* wb = a.ws + WS_WB; (void)wb; pg8::Gemm g{(const bf16_t*)(a.ws + WS_MIX), (const bf16_t*)(wb + WB_WOUT), TOK, DM, DM}; pg8::StaticOrder S; S.init(TOK, DM, G, launder_bid());
            pg8::EpiBf16X<0> E{(bf16_t*)(a.ws + WS_TMP), DM}; GREP(pg8::gemm_phase(gl, g, S, E);); }
        SEAM(b + 7);
        if (RUN(b + 8)) { const Args a = load_args(); rows_phase<1>(a, l, lds); }
        SEAM(b + 8);
        if (RUN(b + 9)) { const Args a = load_args(); unsigned char* wb = a.ws + WS_WB; (void)wb; pg8::Gemm g{(const bf16_t*)(a.ws + WS_H), (const bf16_t*)(wb + WB_W1), TOK, DFF, DM}; pg8::StaticOrder S; S.init(TOK, DFF, G, launder_bid());
            pg8::EpiBf16X<3> E{(bf16_t*)(a.ws + WS_HID), DFF}; GREP(pg8::gemm_phase(gl, g, S, E);); }
        SEAM(b + 9);
        if (RUN(b + 10)) { const Args a = load_args(); unsigned char* wb = a.ws + WS_WB; (void)wb; pg8::Gemm g{(const bf16_t*)(a.ws + WS_HID), (const bf16_t*)(wb + WB_W2), TOK, DM, DFF}; pg8::StaticOrder S; S.init(TOK, DM, G, launder_bid());
            pg8::EpiBf16X<0> E{(bf16_t*)(a.ws + WS_TMP), DM}; GREP(pg8::gemm_phase(gl, g, S, E);); }
        SEAM(b + 10);
    }
    if (RUN(PH_TOTAL - 1)) { const Args a = load_args(); rows_phase<2>(a, NLAYER - 1, lds); }
#undef RUN
#undef SEAM
}

#ifndef MK_NLAUNCH
#define MK_NLAUNCH 1
#endif
extern "C" void kernel_launch(void* const* d_in, const int* in_sizes, int n_in, void* d_out, int out_size, void* d_ws, size_t ws_size, hipStream_t stream) {
    static int grid = 0;
    if (grid == 0) {
        int dev = 0, cus = 0, per_cu = 0;
        if (hipGetDevice(&dev) != hipSuccess || hipDeviceGetAttribute(&cus, hipDeviceAttributeMultiprocessorCount, dev) != hipSuccess) { fprintf(stderr, "device query failed\n"); grid = -1; return; }
        if (hipFuncSetAttribute((const void*)mk_fwd, hipFuncAttributeMaxDynamicSharedMemorySize, LDS_BYTES) != hipSuccess) { fprintf(stderr, "hipFuncSetAttribute failed\n"); grid = -1; return; }
        if (hipOccupancyMaxActiveBlocksPerMultiprocessor(&per_cu, (const void*)mk_fwd, NT, LDS_BYTES) != hipSuccess || per_cu < 1) fprintf(stderr, "occupancy query says %d\n", per_cu);
        (void)hipGetLastError();
        grid = cus;
        if (ws_size < WS_END || n_in != 28) { fprintf(stderr, "workspace %zu < %zu or n_in %d\n", ws_size, (size_t)WS_END, n_in); grid = -1; return; }
    }
    if (grid < 0) return;
    if (hipMemsetAsync((char*)d_ws + WS_CTR, 0, 4096 + 16384, stream) != hipSuccess) { fprintf(stderr, "memset failed\n"); return; }
    Args a{};
    for (int i = 0; i < 28; ++i) a.in[i] = (const float*)d_in[i];
    a.out = (float*)d_out; a.ws = (unsigned char*)d_ws;
    if (MK_NLAUNCH == 1) {
        a.ph_lo = 0; a.ph_hi = PH_TOTAL;
        void* args[] = {&a};
        hipError_t e = hipLaunchCooperativeKernel((const void*)mk_fwd, dim3(grid), dim3(NT), args, LDS_BYTES, stream);
        if (e != hipSuccess) fprintf(stderr, "cooperative launch failed: %s (grid %d)\n", hipGetErrorString(e), grid);
    } else {
        for (int ph = 0; ph < PH_TOTAL; ++ph) { a.ph_lo = ph; a.ph_hi = ph + 1; hipLaunchKernelGGL(mk_fwd, dim3(grid), dim3(NT), LDS_BYTES, stream, a); }
    }
}
```

```cpp
#include <hip/hip_runtime.h>
#include <hip/hip_cooperative_groups.h>
#include <cstdio>
namespace cg = cooperative_groups;
#ifndef PROBE
#define PROBE 0
#endif
__device__ __forceinline__ int launder_tid() { int t = (int)threadIdx.x; asm volatile("" : "+v"(t)); return t; }
__device__ __forceinline__ int launder_bid() { int t = (int)blockIdx.x; asm volatile("" : "+s"(t)); return t; }
namespace pg8 {
#define PG8_LAS __attribute__((address_space(3)))
typedef unsigned short bf16_t;
typedef short bf16x8 __attribute__((ext_vector_type(8)));
typedef float f32x4 __attribute__((ext_vector_type(4)));
typedef unsigned u32x4 __attribute__((ext_vector_type(4)));
constexpr int BM = 256, BK = 64, HALF = 128, HTB = HALF * BK * 2  , STAGE_BYTES = 8 * HTB, NXCD = 8, WGM = 8;

__host__ __device__ __forceinline__ int lds_byte(int r, int c) { const int st = (r >> 4) * 2 + (c >> 5), rr = r & 15, cc = c & 31, ob = rr * 64 + cc * 2; return st * 1024 + (ob ^ (((ob >> 9) & 1) << 5)); }
__host__ __device__ __forceinline__ void stage_rc(int b, int& R, int& C) { const int st = b / 1024, sb = b % 1024, swz = sb ^ (((sb >> 9) & 1) << 5); R = (st >> 1) * 16 + swz / 64; C = (st & 1) * 32 + (swz % 64) / 2; }
__host__ __device__ __forceinline__ int perm32(int rho) { const int n = rho >> 4, i = rho & 15; return 8 * (i >> 2) + 4 * n + (i & 3); }

struct Unit { int pm, pn; };
struct Gemm { const bf16_t* A; const bf16_t* Bt; int M, N, K; };

struct StaticOrder {
    int nM, nN, nwg, G, c;
    __host__ __device__ void init(int M, int N, int G_, int c_) { nM = M / BM; nN = N / BM; nwg = nM * nN; G = G_; c = c_; }
    __host__ __device__ bool next(int i, Unit& u) const {
        const long L = (long)i * G + c; if (L >= nwg) return false;
        int wgid = (int)L; { const int q = nwg / NXCD, r = nwg % NXCD, xcd = wgid % NXCD, off = wgid / NXCD; wgid = (xcd < r ? xcd * (q + 1) : r * (q + 1) + (xcd - r) * q) + off; }
        const int nig = WGM * nN, gid = wgid / nig, fm = gid * WGM, gsz = (nM - fm) < WGM ? (nM - fm) : WGM;
        u.pm = fm + ((wgid % nig) % gsz); u.pn = (wgid % nig) / gsz; return true;
    }
    __device__ __forceinline__ void a_ready(const Unit&) const {}
    __device__ __forceinline__ void done(const Unit&) const {}
};
__device__ __forceinline__ unsigned cvt_pk_bf16(float lo, float hi) { unsigned r; asm volatile("v_cvt_pk_bf16_f32 %0, %1, %2" : "=v"(r) : "v"(lo), "v"(hi)); return r; }
typedef float f32x2 __attribute__((ext_vector_type(2)));
__device__ __forceinline__ f32x2 gelu_pk(f32x2 v) {
    const f32x2 av = __builtin_elementwise_abs(v), d = av * 0.2316418882f + 1.0f;
    f32x2 t; t.x = __builtin_amdgcn_rcpf(d.x); t.y = __builtin_amdgcn_rcpf(d.y);
    f32x2 q = t * 0.5307027145f + (-0.7265760135f); q = q * t + 0.7107068705f; q = q * t + (-0.142248368f); q = q * t + 0.127414796f; q = q * t;
    const f32x2 s = (v * v) * (-0.72134752044f);
    f32x2 e; e.x = __builtin_amdgcn_exp2f(s.x); e.y = __builtin_amdgcn_exp2f(s.y);
    const f32x2 m = v * (q * e), r = v - m;
    f32x2 o; o.x = v.x < 0.f ? m.x : r.x; o.y = v.y < 0.f ? m.y : r.y; return o;
}

struct EpiF32 {
    static constexpr bool PERM = false, AFTER_DRAIN = false;
    float* C; int ldc; const float* bias;
    __device__ __forceinline__ void operator()(const f32x4 (&acc)[2][2][4][2], const Unit& u, int wr, int wc, int fr, int fq) const {
        const int row0 = u.pm * BM + wr * 64 + fr, col0 = u.pn * BM + wc * 32 + 4 * fq;
        f32x4 bv[2][2];
#pragma unroll
        for (int bj = 0; bj < 2; ++bj)
#pragma unroll
            for (int n = 0; n < 2; ++n) bv[bj][n] = bias ? *(const f32x4*)(bias + col0 + bj * HALF + n * 16) : (f32x4){0.f, 0.f, 0.f, 0.f};
#pragma unroll
        for (int ai = 0; ai < 2; ++ai)
#pragma unroll
            for (int m = 0; m < 4; ++m) { float* rowp = C + (size_t)(row0 + ai * HALF + m * 16) * ldc + col0;
#pragma unroll
                for (int bj = 0; bj < 2; ++bj)
#pragma unroll
                    for (int n = 0; n < 2; ++n) *(f32x4*)(rowp + bj * HALF + n * 16) = acc[ai][bj][m][n] + bv[bj][n]; }
    }
};
template <int ACT  > struct EpiBf16 {
    static constexpr bool PERM = true, AFTER_DRAIN = false;
    bf16_t* O; int ldc; const float* bias; int split_cols; size_t split_stride;
    __device__ __forceinline__ void operator()(const f32x4 (&acc)[2][2][4][2], const Unit& u, int wr, int wc, int fr, int fq) const {
        const int row0 = u.pm * BM + wr * 64 + fr; int colt = u.pn * BM; bf16_t* base = O;
        if (split_cols) { const int t = colt / split_cols; base += (size_t)t * split_stride; colt -= t * split_cols; }
        const int col0 = colt + wc * 32 + 8 * fq, bcol0 = u.pn * BM + wc * 32 + 8 * fq;
        f32x4 bv[2][2];
#pragma unroll
        for (int bj = 0; bj < 2; ++bj)
#pragma unroll
            for (int n = 0; n < 2; ++n) bv[bj][n] = bias ? *(const f32x4*)(bias + bcol0 + bj * HALF + 4 * n) : (f32x4){0.f, 0.f, 0.f, 0.f};
#pragma unroll
        for (int ai = 0; ai < 2; ++ai)
#pragma unroll
            for (int m = 0; m < 4; ++m) { bf16_t* rowp = base + (size_t)(row0 + ai * HALF + m * 16) * ldc + col0;
#pragma unroll
                for (int bj = 0; bj < 2; ++bj) { f32x4 v0 = acc[ai][bj][m][0] + bv[bj][0], v1 = acc[ai][bj][m][1] + bv[bj][1];
                    if (ACT == 1) { f32x2 a = gelu_pk((f32x2){v0[0], v0[1]}), b = gelu_pk((f32x2){v0[2], v0[3]}), c = gelu_pk((f32x2){v1[0], v1[1]}), d = gelu_pk((f32x2){v1[2], v1[3]});
                        v0 = (f32x4){a.x, a.y, b.x, b.y}; v1 = (f32x4){c.x, c.y, d.x, d.y}; }
                    if (ACT == 2) {
#pragma unroll
                        for (int j = 0; j < 4; ++j) { v0[j] = 0.5f * v0[j] * (1.0f + erff(v0[j] * 0.70710678f)); v1[j] = 0.5f * v1[j] * (1.0f + erff(v1[j] * 0.70710678f)); } }
                    u32x4 w; w.x = cvt_pk_bf16(v0[0], v0[1]); w.y = cvt_pk_bf16(v0[2], v0[3]); w.z = cvt_pk_bf16(v1[0], v1[1]); w.w = cvt_pk_bf16(v1[2], v1[3]);
                    *(u32x4*)(rowp + bj * HALF) = w; } }
    }
};
template <int ACT> struct EpiBf16X {
    static constexpr bool PERM = true, AFTER_DRAIN = false;
    bf16_t* O; int ldc;
    __device__ __forceinline__ void operator()(const f32x4 (&acc)[2][2][4][2], const Unit& u, int wr, int wc, int fr, int fq) const {
        const int row0 = u.pm * BM + wr * 64 + fr; const int col0 = u.pn * BM + wc * 32 + 8 * fq;
#pragma unroll
        for (int ai = 0; ai < 2; ++ai)
#pragma unroll
            for (int m = 0; m < 4; ++m) { bf16_t* rowp = O + (size_t)(row0 + ai * HALF + m * 16) * ldc + col0;
#pragma unroll
                for (int bj = 0; bj < 2; ++bj) { f32x4 v0 = acc[ai][bj][m][0], v1 = acc[ai][bj][m][1];
                    if (ACT == 3) {
#pragma unroll
                        for (int j = 0; j < 4; ++j) { float a = fmaxf(v0[j], 0.f), b = fmaxf(v1[j], 0.f); v0[j] = a * a; v1[j] = b * b; } }
                    u32x4 w; w.x = cvt_pk_bf16(v0[0], v0[1]); w.y = cvt_pk_bf16(v0[2], v0[3]); w.z = cvt_pk_bf16(v1[0], v1[1]); w.w = cvt_pk_bf16(v1[2], v1[3]);
                    *(u32x4*)(rowp + bj * HALF) = w; } }
    }
};
struct EpiGlu {
    static constexpr bool PERM = false, AFTER_DRAIN = false;
    float* C; int ldc; const float* bias;
    __device__ __forceinline__ void operator()(const f32x4 (&acc)[2][2][4][2], const Unit& u, int wr, int wc, int fr, int fq) const {
        const int row0 = u.pm * BM + wr * 64 + fr, col0 = u.pn * HALF + wc * 32 + 4 * fq;
#pragma unroll
        for (int n = 0; n < 2; ++n) { const f32x4 bv = *(const f32x4*)(bias + col0 + n * 16), bg = *(const f32x4*)(bias + 512 + col0 + n * 16);
#pragma unroll
            for (int ai = 0; ai < 2; ++ai)
#pragma unroll
                for (int m = 0; m < 4; ++m) { float* p = C + (size_t)(row0 + ai * HALF + m * 16) * ldc + col0 + n * 16;
                    const f32x4 v = acc[ai][0][m][n] + bv, g = acc[ai][1][m][n] + bg; f32x4 o;
#pragma unroll
                    for (int j = 0; j < 4; ++j) o[j] = v[j] / (1.0f + __expf(-g[j]));
                    *(f32x4*)p = o; } }
    }
};
template <class Epi, class Sched>
__device__ __forceinline__ void gemm_phase(PG8_LAS unsigned char* lds, const Gemm g, const Sched& S, const Epi& E) {
    const int tid = launder_tid(), wid = __builtin_amdgcn_readfirstlane(tid >> 6), lane = tid & 63, wr = wid >> 2, wc = wid & 3, fr = lane & 15, fq = lane >> 4;
    const int K = g.K, nt = K / BK;
    unsigned voffA[2], voffB[2];
#pragma unroll
    for (int i = 0; i < 2; ++i) { int R, C; stage_rc(tid * 16 + i * 8192, R, C); const int Rb = Epi::PERM ? ((R & ~31) + perm32(R & 31)) : R;
        voffA[i] = (unsigned)(R * K + C) * 2u; voffB[i] = (unsigned)(Rb * K + C) * 2u; }
    const size_t kstep = (size_t)(BK * 2);
    const size_t hstep = (size_t)HALF * K * 2;
    const size_t tstep = 2 * hstep;
    const unsigned ldsw = (unsigned)wid * 1024u;
    const int aoff = lds_byte(wr * 64 + fr, fq * 8), boff = lds_byte(wc * 32 + fr, fq * 8);
#define PG8_SA(b, h) (((b) * 2 + (h)) * HTB)
#define PG8_SB(b, h) ((4 + (b) * 2 + (h)) * HTB)
#define PG8_STAGE(bufoff, gbase, voff) do { _Pragma("unroll") for (int _i = 0; _i < 2; ++_i) \
        __builtin_amdgcn_global_load_lds((const unsigned*)((const char*)(gbase) + (voff)[_i]), (PG8_LAS unsigned*)(lds + (bufoff) + ldsw + _i * 8192), 16, 0, 0); } while (0)
#define PG8_LDA(dst, b, h) do { _Pragma("unroll") for (int m = 0; m < 4; ++m) _Pragma("unroll") for (int k = 0; k < 2; ++k) dst[m][k] = *(const PG8_LAS bf16x8*)(lds + PG8_SA(b, h) + aoff + m * 2048 + k * 1024); } while (0)
#define PG8_LDB(dst, b, h) do { _Pragma("unroll") for (int n = 0; n < 2; ++n) _Pragma("unroll") for (int k = 0; k < 2; ++k) dst[n][k] = *(const PG8_LAS bf16x8*)(lds + PG8_SB(b, h) + boff + n * 2048 + k * 1024); } while (0)
#define PG8_MMA(ai, bj, At, Bt) do { __builtin_amdgcn_s_setprio(1); _Pragma("unroll") for (int m = 0; m < 4; ++m) _Pragma("unroll") for (int n = 0; n < 2; ++n) _Pragma("unroll") for (int k = 0; k < 2; ++k) \
        acc[ai][bj][m][n] = __builtin_amdgcn_mfma_f32_16x16x32_bf16(Bt[n][k], At[m][k], acc[ai][bj][m][n], 0, 0, 0); __builtin_amdgcn_s_setprio(0); } while (0)
#define PG8_WAIT_V(n) asm volatile("s_waitcnt vmcnt(" #n ")" ::: "memory")
#define PG8_WAIT_L(n) asm volatile("s_waitcnt lgkmcnt(" #n ")" ::: "memory")
#define PG8_BAR __builtin_amdgcn_s_barrier()
#define PG8_SCHED __builtin_amdgcn_sched_barrier(0)
    Unit cur, nxt; int ui = 0;
    if (!S.next(0, cur)) return;
    f32x4 acc[2][2][4][2];
#pragma unroll
    for (int a = 0; a < 2; ++a)
#pragma unroll
        for (int b = 0; b < 2; ++b)
#pragma unroll
            for (int m = 0; m < 4; ++m)
#pragma unroll
                for (int n = 0; n < 2; ++n) acc[a][b][m][n] = (f32x4){0.f, 0.f, 0.f, 0.f};
    bf16x8 At[4][2], B0[2][2], B1[2][2];
    const char* cA = (const char*)g.A + (size_t)cur.pm * tstep; const char* cB = (const char*)g.Bt + (size_t)cur.pn * tstep;
    S.a_ready(cur);
    PG8_STAGE(PG8_SB(0, 0), cB, voffB); PG8_STAGE(PG8_SA(0, 0), cA, voffA); PG8_STAGE(PG8_SB(0, 1), cB + hstep, voffB); PG8_STAGE(PG8_SA(0, 1), cA + hstep, voffA);
    if (wr == 1) PG8_BAR;
    PG8_WAIT_V(4); PG8_BAR;
    PG8_STAGE(PG8_SB(1, 0), cB + kstep, voffB); PG8_STAGE(PG8_SA(1, 0), cA + kstep, voffA); PG8_STAGE(PG8_SB(1, 1), cB + hstep + kstep, voffB);
    PG8_WAIT_V(6); PG8_BAR;
    for (;;) {
        const bool has_next = S.next(ui + 1, nxt);
        const char* nA = has_next ? (const char*)g.A + (size_t)nxt.pm * tstep : cA; const char* nB = has_next ? (const char*)g.Bt + (size_t)nxt.pn * tstep : cB;
        for (int t = 0; t < nt; t += 2) {
            const bool last = (t == nt - 2);
            const char* a1 = cA + (size_t)(t + 1) * kstep;
            const char* a2 = last ? nA : cA + (size_t)(t + 2) * kstep; const char* b2 = last ? nB : cB + (size_t)(t + 2) * kstep;
            const char* a3 = a2 + kstep; const char* b3 = b2 + kstep;
            if (last && has_next) S.a_ready(nxt);
            PG8_LDB(B0, 0, 0); PG8_SCHED; PG8_LDA(At, 0, 0); PG8_STAGE(PG8_SA(1, 1), a1 + hstep, voffA);
            PG8_WAIT_L(8); PG8_BAR; PG8_WAIT_L(0); PG8_MMA(0, 0, At, B0); PG8_BAR; PG8_SCHED;
            PG8_LDB(B1, 0, 1); PG8_STAGE(PG8_SB(0, 0), b2, voffB);
            PG8_BAR; PG8_WAIT_L(0); PG8_MMA(0, 1, At, B1); PG8_BAR;
            PG8_LDA(At, 0, 1); PG8_STAGE(PG8_SA(0, 0), a2, voffA);
            PG8_BAR; PG8_WAIT_L(0); PG8_MMA(1, 0, At, B0); PG8_BAR; PG8_SCHED;
            PG8_STAGE(PG8_SB(0, 1), b2 + hstep, voffB);
            PG8_WAIT_V(6); PG8_BAR; PG8_MMA(1, 1, At, B1); PG8_BAR;
            PG8_LDB(B0, 1, 0); PG8_SCHED; PG8_LDA(At, 1, 0); PG8_STAGE(PG8_SA(0, 1), a2 + hstep, voffA);
            PG8_WAIT_L(8); PG8_BAR; PG8_WAIT_L(0); PG8_MMA(0, 0, At, B0); PG8_BAR; PG8_SCHED;
            PG8_LDB(B1, 1, 1); PG8_STAGE(PG8_SB(1, 0), b3, voffB);
            PG8_BAR; PG8_WAIT_L(0); PG8_MMA(0, 1, At, B1); PG8_BAR;
            PG8_LDA(At, 1, 1); PG8_STAGE(PG8_SA(1, 0), a3, voffA);
            PG8_BAR; PG8_WAIT_L(0); PG8_MMA(1, 0, At, B0); PG8_BAR; PG8_SCHED;
            PG8_STAGE(PG8_SB(1, 1), b3 + hstep, voffB);
            PG8_WAIT_V(6); PG8_BAR; PG8_MMA(1, 1, At, B1); PG8_BAR;
        }
        if constexpr (!Epi::AFTER_DRAIN) { E(acc, cur, wr, wc, fr, fq); S.done(cur); }
        if (!has_next) break;
#pragma unroll
        for (int a = 0; a < 2; ++a)
#pragma unroll
            for (int b = 0; b < 2; ++b)
#pragma unroll
                for (int m = 0; m < 4; ++m)
#pragma unroll
                    for (int n = 0; n < 2; ++n) acc[a][b][m][n] = (f32x4){0.f, 0.f, 0.f, 0.f};
        cur = nxt; cA = nA; cB = nB; ++ui;
    }
    PG8_WAIT_V(0);
    if (wr == 0) PG8_BAR;
    PG8_BAR;
    if constexpr (Epi::AFTER_DRAIN) { E.fused(acc, cur, wr, wc, fr, fq, lds, wid, lane); S.done(cur); }
#undef PG8_SA
#undef PG8_SB
#undef PG8_STAGE
#undef PG8_LDA
#undef PG8_LDB
#undef PG8_MMA
#undef PG8_WAIT_V
#undef PG8_WAIT_L
#undef PG8_BAR
#undef PG8_SCHED
}
}

typedef unsigned short bf16_t;
typedef short bf16x8 __attribute__((ext_vector_type(8)));
typedef float f32x4 __attribute__((ext_vector_type(4)));
constexpr int NT = 512;
constexpr int LDS_BYTES = 136 * 1024;
constexpr int TOK = 24576, DM = 2048, PIN = 6160, NP = 6144, DFF = 8192;
constexpr int NLAYER = 4;
constexpr float EPSN = 1e-6f;
constexpr size_t MiB = 1024 * 1024;
constexpr size_t WS_WB = 0;
constexpr size_t WB_WIN = 0, WB_GLU = WB_WIN + (size_t)NP * DM * 2, WB_WOUT = WB_GLU + (size_t)1024 * 512 * 2, WB_W1 = WB_WOUT + (size_t)DM * DM * 2, WB_W2 = WB_W1 + (size_t)DFF * DM * 2;
static_assert(WB_W2 + (size_t)DFF * DM * 2 <= 97 * MiB, "wb");
constexpr size_t WS_H = 97 * MiB;
constexpr size_t WS_P = 193 * MiB;
constexpr size_t WS_TMP = 193 * MiB;
constexpr size_t WS_HID = 385 * MiB;
constexpr size_t WS_HYIN = 481 * MiB;
constexpr size_t WS_QK = 625 * MiB;
constexpr size_t WS_MIX = 625 * MiB;
constexpr size_t WS_MLH = 721 * MiB;
constexpr size_t WS_S5Y = 817 * MiB;
constexpr size_t WS_S5O = 841 * MiB;
constexpr size_t WS_SCR = 889 * MiB;
constexpr size_t WS_H2T = 921 * MiB;
constexpr size_t WS_G = 926 * MiB;
constexpr size_t WS_FIN = 928 * MiB;
constexpr size_t WS_CTR = 935 * MiB;
constexpr size_t WS_HF0 = WS_H;
constexpr size_t WS_HF1 = WS_H + 40 * MiB;
constexpr size_t WS_VT = WS_S5O;
constexpr size_t WS_KT = 936 * MiB;
constexpr size_t WS_SL = 984 * MiB;
constexpr size_t WS_BJ = 1008 * MiB;
constexpr size_t WS_PMJ = WS_BJ + (size_t)8 * 24576 * 4;
constexpr size_t WS_LOC = WS_PMJ + (size_t)8 * 24576 * 4;
constexpr size_t WS_BLML = WS_LOC + (size_t)8 * 24576 * 4;
constexpr size_t WS_WL = WS_BLML + 64 * 1024;
constexpr size_t WS_END = 1012 * MiB;
static_assert(WS_WL + (size_t)8 * 24576 * 4 <= WS_END, "ws map");
constexpr size_t HF_G1 = (size_t)2 * 512 * 16384;

struct Args { const float* in[28]; float* out; unsigned char* ws; int ph_lo, ph_hi; };

typedef __bf16 bf16x2n_t __attribute__((ext_vector_type(2)));
__device__ __forceinline__ unsigned pk2(float lo, float hi) { bf16x2n_t v; v[0] = (__bf16)lo; v[1] = (__bf16)hi; return __builtin_bit_cast(unsigned, v); }
__device__ __forceinline__ bf16_t f2bf(float f) { return __builtin_bit_cast(bf16_t, (__bf16)f); }
__device__ __forceinline__ float bf2f(bf16_t b) { return __uint_as_float(((unsigned)b) << 16); }
__device__ __forceinline__ float bflo(unsigned w) { return __uint_as_float(w << 16); }
__device__ __forceinline__ float bfhi(unsigned w) { return __uint_as_float(w & 0xffff0000u); }
__device__ __forceinline__ float sinr(float x) { return __builtin_amdgcn_sinf(x); }
__device__ __forceinline__ float cosr(float x) { return __builtin_amdgcn_cosf(x); }
__device__ __forceinline__ float my_shfl(float v, int src) { return __int_as_float(__builtin_amdgcn_ds_bpermute(src << 2, __float_as_int(v))); }
__device__ __forceinline__ float shflx(float v, int o, int lane) { return my_shfl(v, lane ^ o); }
__device__ __forceinline__ float my_shfl_up(float v, int o, int lane) { return my_shfl(v, lane - o); }
__device__ __forceinline__ float wave_sum(float v) { const int lane = launder_tid() & 63;
#pragma unroll
    for (int o = 32; o >= 1; o >>= 1) v += shflx(v, o, lane);
    return v; }
__device__ __forceinline__ float wave_max(float v) { const int lane = launder_tid() & 63;
#pragma unroll
    for (int o = 32; o >= 1; o >>= 1) v = fmaxf(v, shflx(v, o, lane));
    return v; }
__device__ __forceinline__ float sigmoidf_(float x) { return 1.0f / (1.0f + __expf(-x)); }
__device__ __forceinline__ bool seq_first(int t) { return t == 0 || t == 16384 || t == 20480; }
__device__ __forceinline__ bool seq_last(int t) { return t == 16383 || t == 20479 || t == 24575; }

__device__ __forceinline__ void cvt_tile(const float* __restrict__ src, int ldsrc, int k0, int srccol0, bf16_t* __restrict__ dst, int K, int n0, float* tl) {
    const int tid = launder_tid();
#pragma unroll
    for (int i = 0; i < 8; ++i) { const int kk = (tid >> 4) + 32 * i, nn4 = (tid & 15) * 4;
        const float4 v = *(const float4*)(src + (size_t)(k0 + kk) * ldsrc + srccol0 + nn4);
        tl[(nn4 + 0) * 257 + kk] = v.x; tl[(nn4 + 1) * 257 + kk] = v.y; tl[(nn4 + 2) * 257 + kk] = v.z; tl[(nn4 + 3) * 257 + kk] = v.w; }
    __syncthreads();
#pragma unroll
    for (int i = 0; i < 4; ++i) { const int item = i * NT + tid, nn = item >> 5, ks = (item & 31) * 8; const float* r = tl + nn * 257 + ks;
      uint4 w; w.x = pk2(r[0], r[1]); w.y = pk2(r[2], r[3]); w.z = pk2(r[4], r[5]); w.w = pk2(r[6], r[7]);
      *(uint4*)(dst + (size_t)(n0 + nn) * K + k0 + ks) = w; }
    __syncthreads();
}
constexpr int CVT_EARLY = 768 + 32 + 256, CVT_ALL = CVT_EARLY + 2048;
__device__ __forceinline__ void convert_tile(const Args& a, int l, int t, float* tl);
constexpr int CVT_WIN = 768;
__device__ __forceinline__ void convert_weights(const Args& a, int l, unsigned char* lds) {
    for (int t = launder_bid() + (l == 0 ? 0 : CVT_WIN); t < CVT_EARLY; t += gridDim.x) convert_tile(a, l, t, (float*)lds);
}
__device__ __forceinline__ void convert_tile(const Args& a, int l, int t, float* tl) {
    unsigned char* wb = a.ws + WS_WB;
    const int T0 = 768, T1 = T0 + 32, T2 = T1 + 256, T3 = T2 + 1024;
    {
        if (t < T0) { const int kt = t & 7, ntile = t >> 3; cvt_tile(a.in[3] + (size_t)l * DM * PIN, PIN, kt * 256, ntile * 64, (bf16_t*)(wb + WB_WIN), DM, ntile * 64, tl); }
        else if (t < T1) { const int u = t - T0, kt = u & 1, ntile = u >> 1; const int n0 = ntile * 64, pn = n0 >> 8, bj = (n0 >> 7) & 1, cc = n0 & 127;
            cvt_tile(a.in[21] + (size_t)l * 512 * 1024, 1024, kt * 256, 512 * bj + 128 * pn + cc, (bf16_t*)(wb + WB_GLU), 512, n0, tl); }
        else if (t < T2) { const int u = t - T1, kt = u & 7, ntile = u >> 3; cvt_tile(a.in[25] + (size_t)l * DM * DM, DM, kt * 256, ntile * 64, (bf16_t*)(wb + WB_WOUT), DM, ntile * 64, tl); }
        else if (t < T3) { const int u = t - T2, kt = u & 7, ntile = u >> 3; cvt_tile(a.in[26] + (size_t)l * DM * DFF, DFF, kt * 256, ntile * 64, (bf16_t*)(wb + WB_W1), DM, ntile * 64, tl); }
        else { const int u = t - T3, kt = u & 31, ntile = u >> 5; cvt_tile(a.in[27] + (size_t)l * DFF * DM, DM, kt * 256, ntile * 64, (bf16_t*)(wb + WB_W2), DFF, ntile * 64, tl); }
    }
}

__device__ __forceinline__ void h2_phase(const Args& a, int l) {
    const int lane = launder_tid() & 63, wv = launder_tid() >> 6;
    const float* w1 = a.in[6] + (size_t)l * 33 * 64; const float* b1 = a.in[7] + l * 64; const float* fq = a.in[8] + l * 64;
    const float* w2 = a.in[9] + (size_t)l * 64 * 64; const float* b2 = a.in[10] + l * 64;
    float* H2T = (float*)(a.ws + WS_H2T);
    const float frj = fq[lane], b1j = b1[lane], b2j = b2[lane];
    for (int idx = launder_bid() * 8 + wv; idx < 20480; idx += gridDim.x * 8) {
        const int L = idx < 16384 ? 16384 : 4096, n = idx < 16384 ? idx : idx - 16384;
        const float t = (float)n / (float)(L - 1), w = 6.283185307179586f * (float)n / (float)L;
        float zv = 0.f;
        if (lane == 0) zv = t;
        else if (lane <= 32) { const int i = (lane - 1) & 15; const float f = 1e-4f + (float)i * ((15.0f - 1e-4f) / 15.0f); const float ar = f * w; zv = lane <= 16 ? cosf(ar) : -sinf(ar); }
        float pre = b1j;
        for (int k = 0; k < 33; ++k) pre += my_shfl(zv, k) * w1[k * 64 + lane];
        const float h1 = sinf(frj * pre);
        float pre2 = b2j;
        for (int k = 0; k < 64; ++k) pre2 += my_shfl(h1, k) * w2[k * 64 + lane];
        const float h2 = sinf(frj * pre2);
        float* dst = idx < 16384 ? H2T + (size_t)lane * 16384 + n : H2T + (size_t)64 * 16384 + (size_t)lane * 4096 + n;
        *dst = h2;
    }
}

template <int MODE>
__device__ __forceinline__ void rows_phase(const Args& a, int l, unsigned char* lds) {
    const int tid = launder_tid(), lane = tid & 63, wv = tid >> 6;
    const bool do_gates = (MODE == 0) || (MODE == 2 && l + 1 < NLAYER);
    const bool do_h = (MODE != 2) || (l + 1 < NLAYER);
    const int ln = (MODE == 2) ? l + 1 : l;
    float* Wg = (float*)lds;
    if (do_gates) {
        const float* wsrc = a.in[3] + (size_t)ln * DM * PIN + NP;
        for (int it = tid; it < 2048 * 4; it += NT) { const int k = it >> 2, j4 = (it & 3) * 4; const float4 v = *(const float4*)(wsrc + (size_t)k * PIN + j4);
            Wg[(j4 + 0) * 2048 + k] = v.x; Wg[(j4 + 1) * 2048 + k] = v.y; Wg[(j4 + 2) * 2048 + k] = v.z; Wg[(j4 + 3) * 2048 + k] = v.w; }
        __syncthreads();
    }
    const float* gA = a.in[2] + (size_t)(l * 4 + (MODE == 1 ? 1 : 3)) * DM;
    const float* gH = a.in[2] + (size_t)(MODE == 1 ? l * 4 + 2 : ln * 4 + 0) * DM;
    const bf16_t* TMPp = (const bf16_t*)(a.ws + WS_TMP);
    bf16_t* H = (bf16_t*)(a.ws + WS_H); float* G = (float*)(a.ws + WS_G);
    const float* gb = a.in[23] + ln * 16;
    for (int row = launder_bid() * 8 + wv; row < TOK; row += gridDim.x * 8) {
        float4 x[8];
        float* xo = a.out + (size_t)row * DM;
        if (MODE == 0) { const float* xi = row < 16384 ? a.in[0] + (size_t)row * DM : a.in[1] + (size_t)(row - 16384) * DM;
#pragma unroll
            for (int i = 0; i < 8; ++i) { x[i] = *(const float4*)(xi + i * 256 + lane * 4); *(float4*)(xo + i * 256 + lane * 4) = x[i]; }
        } else {
            float4 tv[8]; float ss = 0.f; const bf16_t* tp = TMPp + (size_t)row * DM;
#pragma unroll
            for (int i = 0; i < 8; ++i) { const uint2 w = *(const uint2*)(tp + i * 256 + lane * 4); tv[i] = make_float4(bflo(w.x), bfhi(w.x), bflo(w.y), bfhi(w.y)); ss += tv[i].x * tv[i].x + tv[i].y * tv[i].y + tv[i].z * tv[i].z + tv[i].w * tv[i].w; }
            ss = wave_sum(ss); const float rs = rsqrtf(ss * (1.0f / DM) + EPSN);
#pragma unroll
            for (int i = 0; i < 8; ++i) { const float4 g = *(const float4*)(gA + i * 256 + lane * 4); float4 xv = *(const float4*)(xo + i * 256 + lane * 4);
                xv.x += tv[i].x * rs * g.x; xv.y += tv[i].y * rs * g.y; xv.z += tv[i].z * rs * g.z; xv.w += tv[i].w * rs * g.w; x[i] = xv; *(float4*)(xo + i * 256 + lane * 4) = xv; }
        }
        if (do_h) {
            float ss = 0.f;
#pragma unroll
            for (int i = 0; i < 8; ++i) ss += x[i].x * x[i].x + x[i].y * x[i].y + x[i].z * x[i].z + x[i].w * x[i].w;
            ss = wave_sum(ss); const float rs = rsqrtf(ss * (1.0f / DM) + EPSN);
            bf16_t* hp = H + (size_t)row * DM;
#pragma unroll
            for (int i = 0; i < 8; ++i) { const float4 g = *(const float4*)(gH + i * 256 + lane * 4);
                x[i].x *= rs * g.x; x[i].y *= rs * g.y; x[i].z *= rs * g.z; x[i].w *= rs * g.w;
                uint2 w; w.x = pk2(x[i].x, x[i].y); w.y = pk2(x[i].z, x[i].w); *(uint2*)(hp + i * 256 + lane * 4) = w; }
            if (do_gates) {
                float mine = 0.f;
#pragma unroll 1
                for (int j = 0; j < 16; ++j) { float p = 0.f;
#pragma unroll
                    for (int i = 0; i < 8; ++i) { const float4 wv4 = *(const float4*)(Wg + j * 2048 + i * 256 + lane * 4); p += x[i].x * wv4.x + x[i].y * wv4.y + x[i].z * wv4.z + x[i].w * wv4.w; }
                    p = wave_sum(p); if (lane == j) mine = p; }
                if (lane < 16) G[(size_t)row * 16 + lane] = mine + gb[lane];
            }
        }
    }
    __syncthreads();
}

__device__ __forceinline__ void conv_decode(int u, int& tt0, int& pc0, int& kind) {
    tt0 = (u / 14) * 64; const int ct = u % 14;
    if (ct < 6) { kind = 0; pc0 = ct * 256; } else if (ct < 10) { kind = 1; pc0 = 2560 + (ct - 6) * 256; } else { kind = 2; pc0 = 4096 + (ct - 10) * 256; }
}
__device__ __forceinline__ void conv_load(const bf16_t* P, int tt0, int pc0, int tid, uint4 (&w)[5]) {
    const bool first = seq_first(tt0), last = seq_last(tt0 + 63);
#pragma unroll
    for (int i = 0; i < 5; ++i) { const int it = tid + i * NT; w[i] = (uint4){0u, 0u, 0u, 0u};
        if (it < 66 * 32) { const int r = it >> 5, sg = it & 31; const bool valid = !((r == 0 && first) || (r == 65 && last));
            if (valid) w[i] = *(const uint4*)(P + (size_t)(tt0 - 1 + r) * NP + pc0 + sg * 8); } }
}
__device__ __forceinline__ void conv_stage(bf16_t* tin, int tid, const uint4 (&w)[5]) {
#pragma unroll
    for (int i = 0; i < 5; ++i) { const int it = tid + i * NT;
        if (it < 66 * 32) { const int r = it >> 5, sg = it & 31; *(uint4*)(tin + r * 264 + sg * 8) = w[i]; } }
}
template <int KIND>
__device__ __forceinline__ void conv_compute(const Args& a, int l, int pc0, int tid, const bf16_t* tin, float* tout) {
    const float* cw = a.in[4] + (size_t)l * 3 * 3584; const float* cb = a.in[5] + (size_t)l * 3584;
    const int cc = tid & 255, t0 = (tid >> 8) * 32, c = pc0 + cc;
    float w0 = 0.f, w1 = 0.f, w2 = 0.f, bias = 0.f;
    if (KIND != 2) { bias = cb[c]; w0 = cw[c]; w1 = cw[3584 + c]; w2 = cw[2 * 3584 + c]; }
    float pv = bf2f(tin[t0 * 264 + cc]), cv = bf2f(tin[(t0 + 1) * 264 + cc]);
#pragma unroll 8
    for (int e = 0; e < 32; ++e) { const int tt = t0 + e; const float nv = bf2f(tin[(tt + 2) * 264 + cc]); float v;
        if (KIND == 2) v = cv;
        else { v = bias + w0 * pv + w1 * cv + w2 * nv; if (KIND == 1) v = v / (1.0f + __expf(-v)) * 0.0625f; }
        tout[cc * 65 + tt] = v; pv = cv; cv = nv; }
}
template <int KIND>
__device__ __forceinline__ void conv_store(const Args& a, int tt0, int pc0, int tid, const float* tout) {
#pragma unroll
    for (int it = 0; it < 4; ++it) { const int cc = (tid >> 3) + 64 * it, ts = (tid & 7) * 8; const float* r = tout + cc * 65 + ts;
      if (KIND == 0) { float* d = (float*)(a.ws + WS_HYIN) + (size_t)(pc0 + cc) * TOK + tt0 + ts; *(float4*)d = make_float4(r[0], r[1], r[2], r[3]); *(float4*)(d + 4) = make_float4(r[4], r[5], r[6], r[7]); }
      else { bf16_t* d = (bf16_t*)(a.ws + (KIND == 1 ? WS_KT : WS_VT)) + (size_t)(pc0 - (KIND == 1 ? 2560 : 4096) + cc) * TOK + tt0 + ts;
          uint4 w; w.x = pk2(r[0], r[1]); w.y = pk2(r[2], r[3]); w.z = pk2(r[4], r[5]); w.w = pk2(r[6], r[7]); *(uint4*)d = w; } }
    if (KIND == 1) {
#pragma unroll
        for (int it = 0; it < 4; ++it) { const int item = it * NT + tid, tt = item >> 5, cs = (item & 31) * 8; const float* r = tout + cs * 65 + tt;
            uint4 w; w.x = pk2(r[0], r[65]); w.y = pk2(r[130], r[195]); w.z = pk2(r[260], r[325]); w.w = pk2(r[390], r[455]);
            *(uint4*)((bf16_t*)(a.ws + WS_QK) + (size_t)(tt0 + tt) * 2048 + (pc0 - 1536) + cs) = w; } }
}
__device__ __forceinline__ void conv_phase(const Args& a, int l, unsigned char* lds) {
    const int tid = launder_tid();
    const bf16_t* P = (const bf16_t*)(a.ws + WS_P);
    const float* cw = a.in[4] + (size_t)l * 3 * 3584; const float* cb = a.in[5] + (size_t)l * 3584;
    bf16_t* QK = (bf16_t*)(a.ws + WS_QK);
    bf16_t* tin = (bf16_t*)lds;
    float* tout = (float*)(lds + 66 * 264 * 2);
    constexpr int NTILE = 384 * 14;
    const int G = (int)gridDim.x;
    uint4 wreg[5];
    { const int u0 = launder_bid(); if (u0 < NTILE) { int tt0, pc0, kind; conv_decode(u0, tt0, pc0, kind); conv_load(P, tt0, pc0, tid, wreg); } }
    for (int u = launder_bid(); u < NTILE; u += G) {
        int tt0, pc0, kind; conv_decode(u, tt0, pc0, kind);
        conv_stage(tin, tid, wreg);
        __syncthreads();
        if (u + G < NTILE) { int tn, pn, kn; conv_decode(u + G, tn, pn, kn); conv_load(P, tn, pn, tid, wreg); }
        if (kind == 0) conv_compute<0>(a, l, pc0, tid, tin, tout); else if (kind == 1) conv_compute<1>(a, l, pc0, tid, tin, tout); else conv_compute<2>(a, l, pc0, tid, tin, tout);
        __syncthreads();
        if (kind == 0) conv_store<0>(a, tt0, pc0, tid, tout); else if (kind == 1) conv_store<1>(a, tt0, pc0, tid, tout); else conv_store<2>(a, tt0, pc0, tid, tout);
        __syncthreads();
    }
    for (int u = launder_bid(); u < TOK / 32; u += gridDim.x) {
#pragma unroll 1
        for (int it = 0; it < 8; ++it) { const int item = it * NT + tid; const int t = u * 32 + (item >> 7), c8 = (item & 127) * 8; const int c = 1536 + c8;
            const uint4 w1 = *(const uint4*)(P + (size_t)t * NP + c);
            uint4 w0 = {0u, 0u, 0u, 0u}, w2 = {0u, 0u, 0u, 0u};
            if (!seq_first(t)) w0 = *(const uint4*)(P + (size_t)(t - 1) * NP + c);
            if (!seq_last(t)) w2 = *(const uint4*)(P + (size_t)(t + 1) * NP + c);
            const unsigned a0[4] = {w0.x, w0.y, w0.z, w0.w}, a1[4] = {w1.x, w1.y, w1.z, w1.w}, a2[4] = {w2.x, w2.y, w2.z, w2.w};
            float o[8];
            const float4 b0 = *(const float4*)(cb + c), b1 = *(const float4*)(cb + c + 4), u0 = *(const float4*)(cw + c), u1 = *(const float4*)(cw + c + 4), v0 = *(const float4*)(cw + 3584 + c), v1 = *(const float4*)(cw + 3584 + c + 4), x0 = *(const float4*)(cw + 2 * 3584 + c), x1 = *(const float4*)(cw + 2 * 3584 + c + 4);
            const float bb[8] = {b0.x, b0.y, b0.z, b0.w, b1.x, b1.y, b1.z, b1.w}, ww0[8] = {u0.x, u0.y, u0.z, u0.w, u1.x, u1.y, u1.z, u1.w}, ww1[8] = {v0.x, v0.y, v0.z, v0.w, v1.x, v1.y, v1.z, v1.w}, ww2[8] = {x0.x, x0.y, x0.z, x0.w, x1.x, x1.y, x1.z, x1.w};
#pragma unroll
            for (int e = 0; e < 8; ++e) { const float p0 = (e & 1) ? bfhi(a0[e >> 1]) : bflo(a0[e >> 1]), p1 = (e & 1) ? bfhi(a1[e >> 1]) : bflo(a1[e >> 1]), p2 = (e & 1) ? bfhi(a2[e >> 1]) : bflo(a2[e >> 1]);
                float v = bb[e] + ww0[e] * p0 + ww1[e] * p1 + ww2[e] * p2; o[e] = v / (1.0f + __expf(-v)); }
            uint4 w; w.x = pk2(o[0], o[1]); w.y = pk2(o[2], o[3]); w.z = pk2(o[4], o[5]); w.w = pk2(o[6], o[7]);
            *(uint4*)(QK + (size_t)t * 2048 + c8) = w; }
    }
}

__device__ __forceinline__ void gate_local_phase(const Args& a) {
    const int tid = launder_tid(), lane = tid & 63, wv = tid >> 6;
    const float* G = (const float*)(a.ws + WS_G);
    float* BJ = (float*)(a.ws + WS_BJ); float* PMJ = (float*)(a.ws + WS_PMJ); float* LOC = (float*)(a.ws + WS_LOC); bf16_t* WL = (bf16_t*)(a.ws + WS_WL); float2* BLML = (float2*)(a.ws + WS_BLML);
    for (int wt = launder_bid() * 8 + wv; wt < 8 * 384; wt += gridDim.x * 8) {
        const int dh = wt / 384, gc = wt % 384, dir = dh >> 2, head = dh & 3;
        const int t = dir ? gc * 64 + 63 - lane : gc * 64 + lane;
        const float ig = G[(size_t)t * 16 + dir * 8 + head], fg = G[(size_t)t * 16 + dir * 8 + 4 + head];
        const float lf = fminf(fg, 0.f) - log1pf(__expf(-fabsf(fg)));
        float b = lf;
#pragma unroll
        for (int o = 1; o < 64; o <<= 1) { const float t2 = my_shfl_up(b, o, lane); if (lane >= o) b += t2; }
        float pm = ig - b;
#pragma unroll
        for (int o = 1; o < 64; o <<= 1) { const float t2 = my_shfl_up(pm, o, lane); if (lane >= o) pm = fmaxf(pm, t2); }
        const float blast = my_shfl(b, 63), ml = wave_max(blast - b + ig);
        const size_t o1 = (size_t)dh * TOK + t;
        BJ[o1] = b; PMJ[o1] = pm; LOC[o1] = ig - b; WL[o1] = f2bf(__expf((ig - b) - (ml - blast)));
        if (lane == 0) BLML[dh * 384 + gc] = make_float2(blast, ml);
    }
}
__device__ __forceinline__ void sloc_phase(const Args& a) {
    const int tid = launder_tid(), lane = tid & 63, wv = tid >> 6, fr = lane & 15, fq = lane >> 4;
    const bf16_t* QK = (const bf16_t*)(a.ws + WS_QK); bf16_t* SL = (bf16_t*)(a.ws + WS_SL);
    const float* PMJ = (const float*)(a.ws + WS_PMJ); const float* LOC = (const float*)(a.ws + WS_LOC);
    for (int wt = launder_bid() * 8 + wv; wt < 8 * 384 * 4; wt += gridDim.x * 8) {
        const int rt = wt & 3, cg = wt >> 2, dh = cg / 384, gc = cg % 384, dir = dh >> 2, head = dh & 3, nb = gc * 64;
        const int j = rt * 16 + fr, tj = dir ? nb + 63 - j : nb + j;
        bf16x8 qf[8];
        { const bf16_t* qrow = QK + (size_t)tj * 2048 + head * 256 + fq * 8;
#pragma unroll
          for (int kk = 0; kk < 8; ++kk) qf[kk] = *(const bf16x8*)(qrow + kk * 32); }
        const float pmj = PMJ[(size_t)dh * TOK + tj];
#pragma unroll
        for (int ct = 0; ct < 4; ++ct) { f32x4 S = (f32x4){0.f, 0.f, 0.f, 0.f};
            const bf16_t* krow = QK + (size_t)(nb + ct * 16 + fr) * 2048 + 1024 + head * 256 + fq * 8;
#pragma unroll
            for (int kk = 0; kk < 8; ++kk) { const bf16x8 kf = *(const bf16x8*)(krow + kk * 32); S = __builtin_amdgcn_mfma_f32_16x16x32_bf16(kf, qf[kk], S, 0, 0, 0); }
            const int s0 = ct * 16 + fq * 4; const float4 lc = *(const float4*)(LOC + (size_t)dh * TOK + nb + s0); const float lcv[4] = {lc.x, lc.y, lc.z, lc.w}; float v[4];
#pragma unroll
            for (int jj = 0; jj < 4; ++jj) { const int sn = s0 + jj, sd = dir ? 63 - sn : sn; v[jj] = (sd <= j) ? S[jj] * __expf(lcv[jj] - pmj) : 0.f; }
            uint2 w; w.x = pk2(v[0], v[1]); w.y = pk2(v[2], v[3]);
            *(uint2*)(SL + ((size_t)dh * 384 + gc) * 4096 + j * 64 + s0) = w; }
    }
}

__device__ __forceinline__ void hf_phase(const Args& a, int l, unsigned char* lds) {
    const int tid = launder_tid(), lane = tid & 63, wv = tid >> 6, fr = lane & 15, fq = lane >> 4;
    const float* w3 = a.in[11] + (size_t)l * 64 * 2048;
    const float* H2T = (const float*)(a.ws + WS_H2T);
    for (int u = launder_bid(); u < 40 * 32; u += gridDim.x) {
        const int nt = u / 32, col0 = (u % 32) * 64;
        const int L = nt < 32 ? 16384 : 4096, n0 = (nt < 32 ? nt : nt - 32) * 512 + wv * 64;
        const float* hsrc = nt < 32 ? H2T : H2T + (size_t)64 * 16384;
        const int o = col0 >> 10, dir = (col0 >> 9) & 1, cb0 = col0 & 511;
        bf16_t* hf = (bf16_t*)(a.ws + (o ? WS_HF1 : WS_HF0)) + (nt < 32 ? 0 : HF_G1);
        float bw[4][16];
#pragma unroll
        for (int ctile = 0; ctile < 4; ++ctile)
#pragma unroll
            for (int kk = 0; kk < 16; ++kk) bw[ctile][kk] = w3[(size_t)(4 * kk + fq) * 2048 + col0 + ctile * 16 + fr];
#pragma unroll 1
        for (int ntile = 0; ntile < 4; ++ntile) {
            const int nb = n0 + ntile * 16;
            float aw[16];
#pragma unroll
            for (int kk = 0; kk < 16; ++kk) aw[kk] = hsrc[(size_t)(4 * kk + fq) * L + nb + fr];
            float tn[4];
#pragma unroll
            for (int jj = 0; jj < 4; ++jj) tn[jj] = (float)(nb + fq * 4 + jj) / (float)(L - 1);
#pragma unroll
            for (int ctile = 0; ctile < 4; ++ctile) { f32x4 acc = (f32x4){0.f, 0.f, 0.f, 0.f};
#pragma unroll
                for (int kk = 0; kk < 16; ++kk) acc = __builtin_amdgcn_mfma_f32_16x16x4f32(aw[kk], bw[ctile][kk], acc, 0, 0, 0);
                const int c = cb0 + ctile * 16 + fr; const float dl = fabsf(-3.0701134573253943f + (float)c * ((-15.350567286626972f + 3.0701134573253943f) / 511.0f));
                uint2 w; w.x = pk2(acc[0] * __expf(-tn[0] * dl), acc[1] * __expf(-tn[1] * dl)); w.y = pk2(acc[2] * __expf(-tn[2] * dl), acc[3] * __expf(-tn[3] * dl));
                *(uint2*)(hf + (size_t)(dir * 512 + c) * L + nb + fq * 4) = w; }
        }
    }
}

constexpr int S5_SEG = 128;
struct S5Dir { float ar, ai, asr, asi; bf16x8 bm[8]; bf16x8 cm[4]; };
__device__ __forceinline__ void s5_coef(const Args& a, int l, int dir, int g, int p, float& ar, float& ai, float& cr, float& ci, float& asr, float& asi) {
    const size_t o1 = (((size_t)l * 2 + dir) * 32 + g) * 64 + p;
    const float lr = fminf(a.in[13][o1], -1e-4f), li = a.in[14][o1];
    const float dt = expf(a.in[15][((size_t)l * 2 + dir) * 32 + g]);
    const float mag = expf(lr * dt); float sn, cs; sincosf(li * dt, &sn, &cs);
    ar = mag * cs; ai = mag * sn;
    const float mags = expf(lr * dt * (float)S5_SEG); sincosf(li * dt * (float)S5_SEG, &sn, &cs); asr = mags * cs; asi = mags * sn;
    const float nr = ar - 1.0f, ni = ai, den = 1.0f / (lr * lr + li * li);
    cr = (nr * lr + ni * li) * den; ci = (ni * lr - nr * li) * den;
}
__device__ __forceinline__ void s5_setup(const Args& a, int l, int dir, int g, int lane, bool need_c, S5Dir& q) {
    const int fr = lane & 15, fq = lane >> 4;
    float cr, ci; s5_coef(a, l, dir, g, lane, q.ar, q.ai, cr, ci, q.asr, q.asi);
    typedef unsigned u32x4_ __attribute__((ext_vector_type(4)));
#pragma unroll
    for (int ct = 0; ct < 8; ++ct) { const int pp = ct * 8 + (fr >> 1), part = fr & 1;
        const float pcr = my_shfl(cr, pp), pci = my_shfl(ci, pp);
        u32x4_ w = {0u, 0u, 0u, 0u};
        if (fq < 2) { const size_t ob = ((((size_t)l * 2 + dir) * 32 + g) * 64 + pp) * 16 + fq * 8; const float4 r0 = *(const float4*)(a.in[16] + ob), r1 = *(const float4*)(a.in[16] + ob + 4), i0 = *(const float4*)(a.in[17] + ob), i1 = *(const float4*)(a.in[17] + ob + 4);
            const float re[8] = {r0.x, r0.y, r0.z, r0.w, r1.x, r1.y, r1.z, r1.w}, im[8] = {i0.x, i0.y, i0.z, i0.w, i1.x, i1.y, i1.z, i1.w}; float v[8];
#pragma unroll
            for (int e = 0; e < 8; ++e) v[e] = part ? (pcr * im[e] + pci * re[e]) : (pcr * re[e] - pci * im[e]);
            w.x = pk2(v[0], v[1]); w.y = pk2(v[2], v[3]); w.z = pk2(v[4], v[5]); w.w = pk2(v[6], v[7]); }
        q.bm[ct] = __builtin_bit_cast(bf16x8, w); }
    if (need_c) {
        const float* cre = a.in[18] + ((((size_t)l * 2 + dir) * 32 + g) * 16 + fr) * 64; const float* cim = a.in[19] + ((((size_t)l * 2 + dir) * 32 + g) * 16 + fr) * 64;
#pragma unroll
        for (int kk = 0; kk < 4; ++kk) { const int p0 = kk * 16 + fq * 4; const float4 r = *(const float4*)(cre + p0), i = *(const float4*)(cim + p0);
            u32x4_ w; w.x = pk2(r.x, -i.x); w.y = pk2(r.y, -i.y); w.z = pk2(r.z, -i.z); w.w = pk2(r.w, -i.w); q.cm[kk] = __builtin_bit_cast(bf16x8, w); }
    }
}
__device__ __forceinline__ void s5_bu(const S5Dir& q, const float* us, float* buf, int bb, int fr, int fq) {
    typedef unsigned u32x4_ __attribute__((ext_vector_type(4)));
    u32x4_ w = {0u, 0u, 0u, 0u};
    if (fq < 2) { const float* ur = us + (bb * 16 + fr) * 16 + fq * 8; const float4 u0 = *(const float4*)ur, u1 = *(const float4*)(ur + 4); w.x = pk2(u0.x, u0.y); w.y = pk2(u0.z, u0.w); w.z = pk2(u1.x, u1.y); w.w = pk2(u1.z, u1.w); }
    const bf16x8 af = __builtin_bit_cast(bf16x8, w);
#pragma unroll
    for (int ct = 0; ct < 8; ++ct) { f32x4 acc = (f32x4){0.f, 0.f, 0.f, 0.f}; acc = __builtin_amdgcn_mfma_f32_16x16x32_bf16(af, q.bm[ct], acc, 0, 0, 0);
#pragma unroll
        for (int jj = 0; jj < 4; ++jj) buf[(fq * 4 + jj) * 132 + ct * 16 + fr] = acc[jj]; }
}
__device__ __forceinline__ void s5_stage_u(const bf16_t* P, int t0, int g, float* us, int lane) {
#pragma unroll
    for (int it = 0; it < 4; ++it) { const int item = it * 64 + lane, tt = item >> 1, hh = (item & 1) * 8;
        const uint4 w = *(const uint4*)(P + (size_t)(t0 + tt) * NP + 3584 + g * 16 + hh);
        float* d = us + tt * 16 + hh; *(float4*)d = make_float4(bflo(w.x), bfhi(w.x), bflo(w.y), bfhi(w.y)); *(float4*)(d + 4) = make_float4(bflo(w.z), bfhi(w.z), bflo(w.w), bfhi(w.w)); }
}
__device__ __forceinline__ void s5_l1_phase(const Args& a, int l, unsigned char* lds) {
    const int tid = launder_tid(), lane = tid & 63, wv = tid >> 6, fr = lane & 15, fq = lane >> 4;
    const bf16_t* P = (const bf16_t*)(a.ws + WS_P); float2* FIN = (float2*)(a.ws + WS_FIN);
    float* us = (float*)lds + wv * (S5_SEG * 16 + 16 * 132);
    float* buf = us + S5_SEG * 16;
    for (int bt = launder_bid(); bt < 768; bt += gridDim.x) {
        const int wt = bt * 8 + wv, sg = wt >> 5, g = wt & 31, t0 = sg * S5_SEG;
        __syncthreads();
        s5_stage_u(P, t0, g, us, lane);
        __syncthreads();
#pragma unroll 1
        for (int dir = 0; dir < 2; ++dir) {
            S5Dir q; s5_setup(a, l, dir, g, lane, false, q);
            float xr = 0.f, xi = 0.f;
#pragma unroll 1
            for (int b = 0; b < 8; ++b) { const int bb = dir ? 7 - b : b;
                s5_bu(q, us, buf, bb, fr, fq);
                __syncthreads();
#pragma unroll
                for (int s = 0; s < 16; ++s) { const int s16 = dir ? 15 - s : s; const float2 bu = *(const float2*)(buf + s16 * 132 + 2 * lane);
                    const float nr = q.ar * xr - q.ai * xi + bu.x, ni = q.ar * xi + q.ai * xr + bu.y; xr = nr; xi = ni; }
                __syncthreads();
            }
            FIN[(((size_t)sg * 2 + dir) * 32 + g) * 64 + lane] = make_float2(xr, xi);
        }
    }
    __syncthreads();
}
template <int DIR>
__device__ __forceinline__ void s5_l3_dir(const Args& a, int l, int sg, int g, int sfirst, int slast, const float* us, float* buf, f32x4 (&acc)[8], int lane, int fr, int fq) {
    const float2* FIN = (const float2*)(a.ws + WS_FIN);
    S5Dir q; s5_setup(a, l, DIR, g, lane, false, q);
    float cmf[32];
    { const float* cre = a.in[18] + ((((size_t)l * 2 + DIR) * 32 + g) * 16 + fr) * 64 + fq * 16; const float* cim = a.in[19] + ((((size_t)l * 2 + DIR) * 32 + g) * 16 + fr) * 64 + fq * 16;
#pragma unroll
      for (int pp = 0; pp < 16; ++pp) { cmf[2 * pp] = cre[pp]; cmf[2 * pp + 1] = -cim[pp]; } }
    float xr = 0.f, xi = 0.f;
    if (DIR == 0) { for (int j = sfirst; j < sg; ++j) { const float2 f = FIN[(((size_t)j * 2 + 0) * 32 + g) * 64 + lane]; const float nr = q.asr * xr - q.asi * xi + f.x, ni = q.asr * xi + q.asi * xr + f.y; xr = nr; xi = ni; } }
    else { for (int j = slast; j > sg; --j) { const float2 f = FIN[(((size_t)j * 2 + 1) * 32 + g) * 64 + lane]; const float nr = q.asr * xr - q.asi * xi + f.x, ni = q.asr * xi + q.asi * xr + f.y; xr = nr; xi = ni; } }
#pragma unroll
    for (int b = 0; b < 8; ++b) {
        const int bb = DIR ? 7 - b : b;
        s5_bu(q, us, buf, bb, fr, fq);
        __syncthreads();
#pragma unroll
        for (int s = 0; s < 16; ++s) { const int s16 = DIR ? 15 - s : s; float2* slot = (float2*)(buf + s16 * 132 + 2 * lane); const float2 bu = *slot;
            const float nr = q.ar * xr - q.ai * xi + bu.x, ni = q.ar * xi + q.ai * xr + bu.y; xr = nr; xi = ni; *slot = make_float2(xr, xi); }
        __syncthreads();
        { const float* xrow = buf + fr * 132 + fq * 32; f32x4 c = acc[bb];
#pragma unroll
          for (int k4 = 0; k4 < 8; ++k4) { const float4 xv = *(const float4*)(xrow + k4 * 4);
              c = __builtin_amdgcn_mfma_f32_16x16x4f32(xv.x, cmf[k4 * 4 + 0], c, 0, 0, 0); c = __builtin_amdgcn_mfma_f32_16x16x4f32(xv.y, cmf[k4 * 4 + 1], c, 0, 0, 0);
              c = __builtin_amdgcn_mfma_f32_16x16x4f32(xv.z, cmf[k4 * 4 + 2], c, 0, 0, 0); c = __builtin_amdgcn_mfma_f32_16x16x4f32(xv.w, cmf[k4 * 4 + 3], c, 0, 0, 0); }
          acc[bb] = c; }
        __syncthreads();
    }
}
__device__ __forceinline__ void s5_l3_task(const Args& a, int l, int bt, unsigned char* lds) {
    const int tid = launder_tid(), lane = tid & 63, wv = tid >> 6, fr = lane & 15, fq = lane >> 4;
    const bf16_t* P = (const bf16_t*)(a.ws + WS_P); bf16_t* Y = (bf16_t*)(a.ws + WS_S5Y);
    float* us = (float*)lds + wv * (S5_SEG * 16 + 16 * 132);
    float* buf = us + S5_SEG * 16;
    const int wt = bt * 8 + wv, sg = wt >> 5, g = wt & 31, t0 = sg * S5_SEG;
    const int sfirst = sg < 128 ? 0 : (sg < 160 ? 128 : 160), slast = sg < 128 ? 127 : (sg < 160 ? 159 : 191);
    __syncthreads();
    s5_stage_u(P, t0, g, us, lane);
    __syncthreads();
    f32x4 acc[8];
#pragma unroll
    for (int b = 0; b < 8; ++b) acc[b] = (f32x4){0.f, 0.f, 0.f, 0.f};
    s5_l3_dir<0>(a, l, sg, g, sfirst, slast, us, buf, acc, lane, fr, fq);
    s5_l3_dir<1>(a, l, sg, g, sfirst, slast, us, buf, acc, lane, fr, fq);
    const float dv = a.in[20][l * 512 + g * 16 + fr];
#pragma unroll
    for (int b = 0; b < 8; ++b)
#pragma unroll
        for (int j = 0; j < 4; ++j) { const int tt = b * 16 + fq * 4 + j; const float y = acc[b][j] + dv * us[tt * 16 + fr];
            const float inner = 0.7978845608028654f * (y + 0.044715f * y * y * y); const float gl = 0.5f * y * (1.0f + tanhf(inner));
            Y[(size_t)(t0 + tt) * 512 + g * 16 + fr] = f2bf(gl); }
}

typedef float f32x2 __attribute__((ext_vector_type(2)));
__device__ __forceinline__ f32x2 rot_mi(f32x2 v) { return (f32x2){v.y, -v.x}; }
__device__ __forceinline__ f32x2 rot_pi(f32x2 v) { return (f32x2){-v.y, v.x}; }
__device__ __forceinline__ f32x2 mul_w(f32x2 d, float c, float s) { return d * c + rot_mi(d) * s; }
__device__ __forceinline__ f32x2 mul_wc(f32x2 d, float c, float s) { return d * c + rot_pi(d) * s; }
template <int L> __device__ __forceinline__ void fft_dif(float2* Xf) {
    const int tid = launder_tid(); f32x2* X = (f32x2*)Xf;
#pragma unroll 1
    for (int q = L / 4; q >= 1; q >>= 2) {
        const float inv4 = 1.0f / (float)(4 * q);
#pragma unroll 2
        for (int i = tid; i < L / 4; i += NT) { const int k = i & (q - 1), j = ((i - k) << 2) + k;
            f32x2 x0, x1, x2, x3;
            if (q == 1) { const f32x4 lo = *(const f32x4*)(X + j), hi = *(const f32x4*)(X + j + 2); x0 = (f32x2){lo.x, lo.y}; x1 = (f32x2){lo.z, lo.w}; x2 = (f32x2){hi.x, hi.y}; x3 = (f32x2){hi.z, hi.w}; }
            else { x0 = X[j]; x1 = X[j + q]; x2 = X[j + 2 * q]; x3 = X[j + 3 * q]; }
            const float f4 = (float)k * inv4; const float c4 = cosr(f4), s4 = sinr(f4), c2 = cosr(2.0f * f4), s2 = sinr(2.0f * f4);
            const f32x2 y0 = x0 + x2, y1 = x1 + x3;
            const f32x2 y2 = mul_w(x0 - x2, c4, s4);
            const f32x2 y3 = rot_mi(mul_w(x1 - x3, c4, s4));
            const f32x2 z0 = y0 + y1, z2 = y2 + y3;
            const f32x2 z1 = mul_w(y0 - y1, c2, s2), z3 = mul_w(y2 - y3, c2, s2);
            if (q == 1) { *(f32x4*)(X + j) = (f32x4){z0.x, z0.y, z1.x, z1.y}; *(f32x4*)(X + j + 2) = (f32x4){z2.x, z2.y, z3.x, z3.y}; }
            else { X[j] = z0; X[j + q] = z1; X[j + 2 * q] = z2; X[j + 3 * q] = z3; } }
        __syncthreads();
    }
}
template <int L> __device__ __forceinline__ void fft_dit_inv(float2* Xf) {
    const int tid = launder_tid(); f32x2* X = (f32x2*)Xf;
#pragma unroll 1
    for (int q = 1; q <= L / 4; q <<= 2) {
        const float inv4 = 1.0f / (float)(4 * q);
#pragma unroll 2
        for (int i = tid; i < L / 4; i += NT) { const int k = i & (q - 1), j = ((i - k) << 2) + k;
            f32x2 z0, z1, z2, z3;
            if (q == 1) { const f32x4 lo = *(const f32x4*)(X + j), hi = *(const f32x4*)(X + j + 2); z0 = (f32x2){lo.x, lo.y}; z1 = (f32x2){lo.z, lo.w}; z2 = (f32x2){hi.x, hi.y}; z3 = (f32x2){hi.z, hi.w}; }
            else { z0 = X[j]; z1 = X[j + q]; z2 = X[j + 2 * q]; z3 = X[j + 3 * q]; }
            const float f4 = (float)k * inv4; const float c4 = cosr(f4), s4 = sinr(f4), c2 = cosr(2.0f * f4), s2 = sinr(2.0f * f4);
            const f32x2 b0 = mul_wc(z1, c2, s2), b1 = mul_wc(z3, c2, s2);
            const f32x2 y0 = z0 + b0, y1 = z0 - b0, y2 = z2 + b1, y3 = z2 - b1;
            const f32x2 g0 = mul_wc(y2, c4, s4);
            const f32x2 g1 = rot_pi(mul_wc(y3, c4, s4));
            const f32x2 x0 = y0 + g0, x2 = y0 - g0, x1 = y1 + g1, x3 = y1 - g1;
            if (q == 1) { *(f32x4*)(X + j) = (f32x4){x0.x, x0.y, x1.x, x1.y}; *(f32x4*)(X + j + 2) = (f32x4){x2.x, x2.y, x3.x, x3.y}; }
            else { X[j] = x0; X[j + q] = x1; X[j + 2 * q] = x2; X[j + 3 * q] = x3; } }
        __syncthreads();
    }
}
__device__ __forceinline__ f32x2 cmul(f32x2 a, f32x2 b) { return (f32x2){a.x * b.x - a.y * b.y, a.x * b.y + a.y * b.x}; }
__device__ __forceinline__ f32x2 cconj(f32x2 a) { return (f32x2){a.x, -a.y}; }
template <int L, int NSEQ>
__device__ __forceinline__ void hyena_task(const Args& a, int l, int c, unsigned char* lds) {
    constexpr int HP = L / 2 / NT;
    constexpr int LOGN = (L == 16384) ? 14 : 12;
    const int tid = launder_tid();
    f32x2* X = (f32x2*)lds;
    float* red = (float*)(lds + 131072);
    f32x2* SCR = (f32x2*)(a.ws + WS_SCR) + (size_t)launder_bid() * 16384;
    float* HYIN = (float*)(a.ws + WS_HYIN);
    const int tok0 = (L == 16384) ? 0 : 16384;
    f32x2 y[NSEQ][HP];
    float* zrow = HYIN + (size_t)c * TOK + tok0;
    __syncthreads();
#pragma unroll 1
    for (int o = 0; o < 2; ++o) {
        const bf16_t* hfw = (const bf16_t*)(a.ws + (o ? WS_HF1 : WS_HF0)) + (L == 16384 ? 0 : HF_G1) + (size_t)c * L;
        const bf16_t* hbw = (const bf16_t*)(a.ws + (o ? WS_HF1 : WS_HF0)) + (L == 16384 ? 0 : HF_G1) + (size_t)(512 + c) * L;
        float ssq = 0.f;
#pragma unroll 4
        for (int e = 0; e < 2 * HP; ++e) { const int n = tid + NT * e; const float Av = bf2f(hfw[n]); const float Bw = n >= 1 ? bf2f(hbw[n]) : 0.f; ssq += Av * Av + Bw * Bw; }
        ssq = wave_sum(ssq);
        if ((tid & 63) == 0) red[tid >> 6] = ssq;
        __syncthreads();
        float tot = 0.f;
#pragma unroll
        for (int w = 0; w < 8; ++w) tot += red[w];
        const float nrm = rsqrtf(tot + EPSN) * (1.0f / (float)L);
#pragma unroll 4
        for (int e = 0; e < 2 * HP; ++e) { const int n = tid + NT * e; f32x2 v;
            if (n < L / 2) { const unsigned w = *(const unsigned*)(hfw + 2 * n); v = (f32x2){bflo(w), bfhi(w)}; }
            else { const int m = 2 * n; v = (f32x2){m == L ? 0.f : bf2f(hbw[2 * L - m]), bf2f(hbw[2 * L - m - 1])}; }
            X[n] = v; }
        __syncthreads();
        fft_dif<L>((float2*)X);
#pragma unroll 4
        for (int e = 0; e < HP; ++e) { const int k = tid + NT * e;
            if (k == 0) { const f32x2 z0 = X[0]; SCR[0] = (f32x2){z0.x + z0.y, z0.x - z0.y}; }
            else { const int j = (int)(__brev((unsigned)k) >> (32 - LOGN)), jn = (int)(__brev((unsigned)(L - k)) >> (32 - LOGN));
                const f32x2 A = X[j], B = cconj(X[jn]); const f32x2 E = (A + B) * 0.5f, D = A - B; const f32x2 O = (f32x2){0.5f * D.y, -0.5f * D.x};
                const float fr = (float)k * (1.0f / (float)(2 * L)); const f32x2 wO = mul_w(O, cosr(fr), sinr(fr));
                SCR[k] = E + wO; SCR[L - k] = cconj(E - wO); } }
        if (tid == 0) SCR[L / 2] = cconj(X[1]);
#pragma unroll
        for (int s = 0; s < NSEQ; ++s) {
            __syncthreads();
#pragma unroll 4
            for (int e = 0; e < 2 * HP; ++e) { const int n = tid + NT * e; f32x2 v = (f32x2){0.f, 0.f}; if (n < L / 2) v = *(const f32x2*)(zrow + s * L + 2 * n); X[n] = v; }
            __syncthreads();
            fft_dif<L>((float2*)X);
#pragma unroll 4
            for (int e = 0; e < HP; ++e) { const int k = tid + NT * e;
                if (k == 0) { const f32x2 z0 = X[0], k0 = SCR[0]; const float y0 = (z0.x + z0.y) * k0.x, yn = (z0.x - z0.y) * k0.y; X[0] = (f32x2){0.5f * (y0 + yn), 0.5f * (y0 - yn)}; }
                else { const int j = (int)(__brev((unsigned)k) >> (32 - LOGN)), jn = (int)(__brev((unsigned)(L - k)) >> (32 - LOGN));
                    const f32x2 A = X[j], B = cconj(X[jn]); const f32x2 E = (A + B) * 0.5f, D = A - B; const f32x2 O = (f32x2){0.5f * D.y, -0.5f * D.x};
                    const float fr = (float)k * (1.0f / (float)(2 * L)); const float cw = cosr(fr), sw = sinr(fr); const f32x2 wO = mul_w(O, cw, sw);
                    const f32x2 Yk = cmul(E + wO, SCR[k]), Yn = cconj(cmul(cconj(E - wO), SCR[L - k]));
                    const f32x2 Ep = (Yk + Yn) * 0.5f, Op = mul_wc((Yk - Yn) * 0.5f, cw, sw);
                    X[j] = Ep + rot_pi(Op); X[jn] = cconj(Ep) + rot_pi(cconj(Op)); } }
            if (tid == 0) { const f32x2 A = X[1]; X[1] = cconj(cmul(cconj(A), SCR[L / 2])); }
            __syncthreads();
            fft_dit_inv<L>((float2*)X);
#pragma unroll
            for (int e = 0; e < HP; ++e) y[s][e] = X[tid + NT * e];
        }
        __syncthreads();
        const float sk = a.in[12][((size_t)l * 2 + o) * 512 + c];
#pragma unroll
        for (int s = 0; s < NSEQ; ++s)
#pragma unroll
            for (int e = 0; e < HP; ++e) { const int n = tid + NT * e; const f32x2 gt = *(const f32x2*)(HYIN + (size_t)((o + 1) * 512 + c) * TOK + tok0 + s * L + 2 * n); const f32x2 zo = *(const f32x2*)(zrow + s * L + 2 * n);
                *(f32x2*)(zrow + s * L + 2 * n) = gt * (y[s][e] * nrm + zo * sk); if ((e & 3) == 3) asm volatile("" ::: "memory"); }
    }
}

__device__ __forceinline__ bf16x8 scale_bf16x8(bf16x8 v, const float (&w)[8]) {
    typedef unsigned u32x4_ __attribute__((ext_vector_type(4)));
    const u32x4_ u = __builtin_bit_cast(u32x4_, v); u32x4_ r;
    r.x = pk2(bflo(u.x) * w[0], bfhi(u.x) * w[1]); r.y = pk2(bflo(u.y) * w[2], bfhi(u.y) * w[3]); r.z = pk2(bflo(u.z) * w[4], bfhi(u.z) * w[5]); r.w = pk2(bflo(u.w) * w[6], bfhi(u.w) * w[7]);
    return __builtin_bit_cast(bf16x8, r);
}
constexpr int ML_NVT = 4, ML_VB = ML_NVT * 16, ML_ROWS = (ML_NVT + 1) * 16, ML_NVS = 256 / ML_VB;
struct MlCtx { const bf16_t* QK; const bf16_t* SL; const bf16_t* KT; const bf16_t* VT; const float* BJ; const float* PMJ; const bf16_t* WL; const float2* BLML; bf16_t* MLH; bf16_t* CTb0; bf16_t* VST;
               int dir, tok0, L, head, vs, dh, lane, fr, fq, rw; };
struct MlOutSet { bf16x8 qf[8], sf[2], vf[ML_NVT][2]; float pmv, bjv; float2 bm; };
struct MlUpdSet { bf16x8 kf[4][2], lc[2]; float2 bm; };
__device__ __forceinline__ int ml_nb(const MlCtx& x, int cc) { return x.dir ? x.tok0 + x.L - 64 * (cc + 1) : x.tok0 + 64 * cc; }
__device__ __forceinline__ void ml_load_out(const MlCtx& x, MlOutSet& s, int cc) {
    const int nb = ml_nb(x, cc), gc = nb >> 6, jrow = x.rw * 16 + x.fr, tj = x.dir ? nb + 63 - jrow : nb + jrow; const bf16_t* qrow = x.QK + (tj * 2048 + x.head * 256 + x.fq * 8);
#pragma unroll
    for (int kk = 0; kk < 8; ++kk) s.qf[kk] = *(const bf16x8*)(qrow + kk * 32);
    const bf16_t* srow = x.SL + ((x.dh * 384 + gc) * 4096 + jrow * 64 + x.fq * 8); s.sf[0] = *(const bf16x8*)(srow); s.sf[1] = *(const bf16x8*)(srow + 32);
#pragma unroll
    for (int vt = 0; vt < ML_NVT; ++vt) { const bf16_t* vrow = x.VT + ((vt * 16 + x.fr) * TOK + nb + x.fq * 8); s.vf[vt][0] = *(const bf16x8*)(vrow); s.vf[vt][1] = *(const bf16x8*)(vrow + 32); }
    s.pmv = x.PMJ[tj]; s.bjv = x.BJ[tj];
    s.bm = x.BLML[gc];
}
__device__ __forceinline__ void ml_load_upd(const MlCtx& x, MlUpdSet& s, int cc) {
    const int nb = ml_nb(x, cc);
#pragma unroll
    for (int di = 0; di < 4; ++di) { const bf16_t* krow = x.KT + (((x.rw * 4 + di) * 16 + x.fr) * TOK + nb + x.fq * 8); s.kf[di][0] = *(const bf16x8*)(krow); s.kf[di][1] = *(const bf16x8*)(krow + 32); }
#pragma unroll
    for (int kk = 0; kk < 2; ++kk) s.lc[kk] = *(const bf16x8*)(x.WL + nb + kk * 32 + x.fq * 8);
    s.bm = x.BLML[nb >> 6];
}
#define ML_BAR() do { asm volatile("s_waitcnt lgkmcnt(0)" ::: "memory"); __builtin_amdgcn_s_barrier(); asm volatile("" ::: "memory"); } while (0)
__device__ __forceinline__ void ml_publish_v(const MlCtx& x, const MlOutSet& s, int cc) {
    bf16_t* dst = x.VST + (cc & 1) * (ML_NVT * 1024) + x.lane * 8;
#pragma unroll
    for (int vt = 0; vt < ML_NVT; ++vt) { *(bf16x8*)(dst + vt * 1024) = s.vf[vt][0]; *(bf16x8*)(dst + vt * 1024 + 512) = s.vf[vt][1]; }
}
__device__ __forceinline__ void ml_out_step(const MlCtx& x, MlOutSet& s, const MlOutSet& sn, int c, int nchunk, float& m) {
    const int nb = ml_nb(x, c);
    const bf16_t* CTb = x.CTb0 + (c & 1) * (ML_ROWS * 264);
    const int jrow = x.rw * 16 + x.fr, tj = x.dir ? nb + 63 - jrow : nb + jrow;
    const float mx = fmaxf(m, s.pmv); float inter = __expf(m - mx), rsc = __expf(s.pmv - mx); const float emt = __expf(-s.bjv - mx);
    const float mnew = fmaxf(s.bm.x + m, s.bm.y);
    bf16x8 bA[8];
    { const bf16_t* crow = CTb + (ML_NVT * 16 + x.fr) * 264 + x.fq * 8;
#pragma unroll
      for (int kk = 0; kk < 8; ++kk) bA[kk] = *(const bf16x8*)(crow + kk * 32);
      f32x4 Oc = (f32x4){0.f, 0.f, 0.f, 0.f}, Os = (f32x4){0.f, 0.f, 0.f, 0.f};
#pragma unroll
      for (int kk = 0; kk < 8; ++kk) Oc = __builtin_amdgcn_mfma_f32_16x16x32_bf16(bA[kk], s.qf[kk], Oc, 0, 0, 0);
      const short one = (x.fr == 0) ? (short)0x3F80 : (short)0; const bf16x8 ones = {one, one, one, one, one, one, one, one};
#pragma unroll
      for (int kk = 0; kk < 2; ++kk) Os = __builtin_amdgcn_mfma_f32_16x16x32_bf16(ones, s.sf[kk], Os, 0, 0, 0);
      float den = inter * Oc[0] + rsc * Os[0]; den = my_shfl(den, x.lane & 15);
      const float dnv = 1.0f / fmaxf(fabsf(den), emt); inter *= dnv; rsc *= dnv; }
#pragma unroll
    for (int ct = 0; ct < ML_NVT; ++ct) {
        __builtin_amdgcn_sched_barrier(0);
        { const bf16_t* crow = CTb + (ct * 16 + x.fr) * 264 + x.fq * 8;
#pragma unroll
          for (int kk = 0; kk < 8; ++kk) bA[kk] = *(const bf16x8*)(crow + kk * 32); }
        __builtin_amdgcn_sched_barrier(0);
        f32x4 Oc = (f32x4){0.f, 0.f, 0.f, 0.f}, Os = (f32x4){0.f, 0.f, 0.f, 0.f};
#pragma unroll
        for (int kk = 0; kk < 8; ++kk) Oc = __builtin_amdgcn_mfma_f32_16x16x32_bf16(bA[kk], s.qf[kk], Oc, 0, 0, 0);
#pragma unroll
        for (int kk = 0; kk < 2; ++kk) Os = __builtin_amdgcn_mfma_f32_16x16x32_bf16(s.vf[ct][kk], s.sf[kk], Os, 0, 0, 0);
        uint2 w_; w_.x = pk2(inter * Oc[0] + rsc * Os[0], inter * Oc[1] + rsc * Os[1]); w_.y = pk2(inter * Oc[2] + rsc * Os[2], inter * Oc[3] + rsc * Os[3]);
        *(uint2*)(x.MLH + (tj * 1024 + x.head * 256 + x.vs * ML_VB + ct * 16 + x.fq * 4)) = w_; }
    __builtin_amdgcn_sched_barrier(0);
    if (c + 2 < nchunk) ml_load_out(x, s, c + 2);
    __builtin_amdgcn_sched_barrier(0);
    m = mnew;
    if (c + 1 < nchunk) ml_publish_v(x, sn, c + 1);
    ML_BAR();
}
__device__ __forceinline__ void ml_upd_step(const MlCtx& x, MlUpdSet& s, f32x4 (&CT)[ML_NVT + 1][4], int c, int nchunk, float& m) {
    bf16_t* CTn = x.CTb0 + ((c + 1) & 1) * (ML_ROWS * 264);
    const float mnew = fmaxf(s.bm.x + m, s.bm.y), decay = __expf(s.bm.x + m - mnew), wsc = __expf(s.bm.y - mnew);
    bf16x8 an[2], vf[ML_NVT][2];
    { const bf16_t* src = x.VST + (c & 1) * (ML_NVT * 1024) + x.lane * 8;
#pragma unroll
      for (int vt = 0; vt < ML_NVT; ++vt) { vf[vt][0] = *(const bf16x8*)(src + vt * 1024); vf[vt][1] = *(const bf16x8*)(src + vt * 1024 + 512); } }
#pragma unroll
    for (int kk = 0; kk < 2; ++kk) { typedef unsigned u32x4_ __attribute__((ext_vector_type(4))); const u32x4_ lw = __builtin_bit_cast(u32x4_, s.lc[kk]);
        const float w8[8] = {bflo(lw.x) * wsc, bfhi(lw.x) * wsc, bflo(lw.y) * wsc, bfhi(lw.y) * wsc, bflo(lw.z) * wsc, bfhi(lw.z) * wsc, bflo(lw.w) * wsc, bfhi(lw.w) * wsc};
#pragma unroll
        for (int di = 0; di < 4; ++di) s.kf[di][kk] = scale_bf16x8(s.kf[di][kk], w8);
        const short one = (x.fr == 0) ? (short)0x3F80 : (short)0; an[kk] = (bf16x8){one, one, one, one, one, one, one, one}; }
#pragma unroll
    for (int vt = 0; vt < ML_NVT + 1; ++vt)
#pragma unroll
        for (int di = 0; di < 4; ++di) { f32x4 cacc = CT[vt][di] * decay;
            cacc = __builtin_amdgcn_mfma_f32_16x16x32_bf16(s.kf[di][0], vt < ML_NVT ? vf[vt < ML_NVT ? vt : 0][0] : an[0], cacc, 0, 0, 0); cacc = __builtin_amdgcn_mfma_f32_16x16x32_bf16(s.kf[di][1], vt < ML_NVT ? vf[vt < ML_NVT ? vt : 0][1] : an[1], cacc, 0, 0, 0);
            CT[vt][di] = cacc; }
    __builtin_amdgcn_sched_barrier(0);
    if (c + 2 < nchunk) ml_load_upd(x, s, c + 2);
    __builtin_amdgcn_sched_barrier(0);
#pragma unroll
    for (int vt = 0; vt < ML_NVT + 1; ++vt)
#pragma unroll
        for (int di = 0; di < 4; ++di)
            { uint2 w_; w_.x = pk2(CT[vt][di][0], CT[vt][di][1]); w_.y = pk2(CT[vt][di][2], CT[vt][di][3]); *(uint2*)(CTn + (vt * 16 + x.fr) * 264 + (x.rw * 4 + di) * 16 + x.fq * 4) = w_; }
    m = mnew;
    ML_BAR();
}
__device__ __forceinline__ void mlstm_task(const Args& a, int task, unsigned char* lds) {
    const int tid = launder_tid(), lane = tid & 63, wv = tid >> 6;
    int seq, rem; if (task < 8 * ML_NVS) { seq = 0; rem = task; } else { seq = 1 + (task - 8 * ML_NVS) / (8 * ML_NVS); rem = (task - 8 * ML_NVS) % (8 * ML_NVS); }
    MlCtx x;
    x.vs = rem % ML_NVS; x.dir = (rem / ML_NVS) & 1; x.head = rem / (2 * ML_NVS); x.dh = x.dir * 4 + x.head; x.lane = lane; x.fr = lane & 15; x.fq = lane >> 4; x.rw = wv & 3;
    x.L = seq == 0 ? 16384 : 4096; x.tok0 = seq == 0 ? 0 : 16384 + (seq - 1) * 4096; const int nchunk = x.L / 64;
    x.QK = (const bf16_t*)(a.ws + WS_QK); x.SL = (const bf16_t*)(a.ws + WS_SL);
    x.KT = (const bf16_t*)(a.ws + WS_KT) + (size_t)x.head * 256 * TOK; x.VT = (const bf16_t*)(a.ws + WS_VT) + (size_t)(x.head * 256 + x.vs * ML_VB) * TOK;
    x.BJ = (const float*)(a.ws + WS_BJ) + (size_t)x.dh * TOK; x.PMJ = (const float*)(a.ws + WS_PMJ) + (size_t)x.dh * TOK; x.WL = (const bf16_t*)(a.ws + WS_WL) + (size_t)x.dh * TOK;
    x.BLML = (const float2*)(a.ws + WS_BLML) + x.dh * 384;
    x.MLH = (bf16_t*)(a.ws + WS_MLH) + (size_t)x.dir * TOK * 1024;
    x.VST = (bf16_t*)(lds + 2 * ML_ROWS * 264 * 2);
    x.CTb0 = (bf16_t*)lds;
    __syncthreads();
    for (int i = tid; i < ML_ROWS * 264; i += NT) x.CTb0[i] = 0;
    __syncthreads();
    float m = 0.f;
    if (wv < 4) {
        MlOutSet s0, s1;
        ml_load_out(x, s0, 0); ml_load_out(x, s1, 1);
        ml_publish_v(x, s0, 0); ML_BAR();
#pragma unroll 1
        for (int c = 0; c < nchunk; c += 4) { ml_out_step(x, s0, s1, c, nchunk, m); ml_out_step(x, s1, s0, c + 1, nchunk, m); ml_out_step(x, s0, s1, c + 2, nchunk, m); ml_out_step(x, s1, s0, c + 3, nchunk, m); }
    } else {
        f32x4 CT[ML_NVT + 1][4];
#pragma unroll
        for (int i = 0; i < ML_NVT + 1; ++i)
#pragma unroll
            for (int j = 0; j < 4; ++j) CT[i][j] = (f32x4){0.f, 0.f, 0.f, 0.f};
        MlUpdSet s0, s1;
        ml_load_upd(x, s0, 0); ml_load_upd(x, s1, 1);
        ML_BAR();
#pragma unroll 1
        for (int c = 0; c < nchunk; c += 4) { ml_upd_step(x, s0, CT, c, nchunk, m); ml_upd_step(x, s1, CT, c + 1, nchunk, m); ml_upd_step(x, s0, CT, c + 2, nchunk, m); ml_upd_step(x, s1, CT, c + 3, nchunk, m); }
    }
    __syncthreads();
}
#undef ML_BAR

__device__ __forceinline__ void groupnorm_phase(const Args& a, int l, unsigned char* lds) {
    const int tid = launder_tid(), tt = tid >> 4, sub = tid & 15;
    const float* gn = a.in[24] + (size_t)l * 2048;
    const float* HYIN = (const float*)(a.ws + WS_HYIN); const float* S5O = (const float*)(a.ws + WS_S5O); const bf16_t* MLH = (const bf16_t*)(a.ws + WS_MLH);
    const bf16_t* P = (const bf16_t*)(a.ws + WS_P); bf16_t* MIX = (bf16_t*)(a.ws + WS_MIX);
    float* hy = (float*)lds;
    for (int u = launder_bid(); u < TOK / 32; u += gridDim.x) {
        const int t0 = u * 32, t = t0 + tt;
        __syncthreads();
#pragma unroll
        for (int it = 0; it < 8; ++it) { const int c = (tid >> 3) + 64 * it, sg = (tid & 7) * 4; const float4 v = *(const float4*)(HYIN + (size_t)c * TOK + t0 + sg);
            float* d = hy + c * 33 + sg; d[0] = v.x; d[1] = v.y; d[2] = v.z; d[3] = v.w; }
        __syncthreads();
        { float ss = 0.f;
#pragma unroll
          for (int i = 0; i < 32; ++i) { const float v = hy[(sub + 16 * i) * 33 + tt]; ss += v * v; }
          ss += shflx(ss, 1, tid & 63); ss += shflx(ss, 2, tid & 63); ss += shflx(ss, 4, tid & 63); ss += shflx(ss, 8, tid & 63);
          const float rs = rsqrtf(ss * (1.0f / 512.0f) + EPSN);
#pragma unroll
          for (int i = 0; i < 4; ++i) { const int c0 = sub * 8 + 128 * i; float o[8];
              const float4 g0 = *(const float4*)(gn + c0), g1 = *(const float4*)(gn + c0 + 4); const float gg[8] = {g0.x, g0.y, g0.z, g0.w, g1.x, g1.y, g1.z, g1.w};
#pragma unroll
              for (int e = 0; e < 8; ++e) o[e] = hy[(c0 + e) * 33 + tt] * rs * gg[e];
              uint4 w; w.x = pk2(o[0], o[1]); w.y = pk2(o[2], o[3]); w.z = pk2(o[4], o[5]); w.w = pk2(o[6], o[7]);
              *(uint4*)(MIX + (size_t)t * 2048 + c0) = w; } }
        { float4 v[8]; float ss = 0.f;
#pragma unroll
          for (int i = 0; i < 8; ++i) { v[i] = *(const float4*)(S5O + (size_t)t * 512 + i * 64 + sub * 4); ss += v[i].x * v[i].x + v[i].y * v[i].y + v[i].z * v[i].z + v[i].w * v[i].w; }
          ss += shflx(ss, 1, tid & 63); ss += shflx(ss, 2, tid & 63); ss += shflx(ss, 4, tid & 63); ss += shflx(ss, 8, tid & 63);
          const float rs = rsqrtf(ss * (1.0f / 512.0f) + EPSN);
#pragma unroll
          for (int i = 0; i < 8; ++i) { const int c0 = i * 64 + sub * 4; const float4 g = *(const float4*)(gn + 512 + c0);
              uint2 w; w.x = pk2(v[i].x * rs * g.x, v[i].y * rs * g.y); w.y = pk2(v[i].z * rs * g.z, v[i].w * rs * g.w); *(uint2*)(MIX + (size_t)t * 2048 + 512 + c0) = w; } }
#pragma unroll 1
        for (int hd = 0; hd < 4; ++hd) { float hv[16]; float ss = 0.f;
#pragma unroll
            for (int i = 0; i < 2; ++i) { const int c0 = hd * 256 + sub * 8 + 128 * i; const uint4 wf = *(const uint4*)(MLH + (size_t)t * 1024 + c0), wb = *(const uint4*)(MLH + (size_t)TOK * 1024 + (size_t)t * 1024 + c0);
                hv[i * 8 + 0] = bflo(wf.x) + bflo(wb.x); hv[i * 8 + 1] = bfhi(wf.x) + bfhi(wb.x); hv[i * 8 + 2] = bflo(wf.y) + bflo(wb.y); hv[i * 8 + 3] = bfhi(wf.y) + bfhi(wb.y);
                hv[i * 8 + 4] = bflo(wf.z) + bflo(wb.z); hv[i * 8 + 5] = bfhi(wf.z) + bfhi(wb.z); hv[i * 8 + 6] = bflo(wf.w) + bflo(wb.w); hv[i * 8 + 7] = bfhi(wf.w) + bfhi(wb.w); }
#pragma unroll
            for (int e = 0; e < 16; ++e) ss += hv[e] * hv[e];
            ss += shflx(ss, 1, tid & 63); ss += shflx(ss, 2, tid & 63); ss += shflx(ss, 4, tid & 63); ss += shflx(ss, 8, tid & 63);
            const float rs = rsqrtf(ss * (1.0f / 256.0f) + EPSN);
#pragma unroll
            for (int i = 0; i < 2; ++i) { const int c0 = hd * 256 + sub * 8 + 128 * i; const uint4 wo = *(const uint4*)(P + (size_t)t * NP + 5120 + c0);
                const float og[8] = {bflo(wo.x), bfhi(wo.x), bflo(wo.y), bfhi(wo.y), bflo(wo.z), bfhi(wo.z), bflo(wo.w), bfhi(wo.w)}; float o[8];
                const float4 q0 = *(const float4*)(gn + 1024 + c0), q1 = *(const float4*)(gn + 1024 + c0 + 4); const float gq[8] = {q0.x, q0.y, q0.z, q0.w, q1.x, q1.y, q1.z, q1.w};
#pragma unroll
                for (int e = 0; e < 8; ++e) o[e] = hv[i * 8 + e] * rs * gq[e] * sigmoidf_(og[e]);
                uint4 w; w.x = pk2(o[0], o[1]); w.y = pk2(o[2], o[3]); w.z = pk2(o[4], o[5]); w.w = pk2(o[6], o[7]);
                *(uint4*)(MIX + (size_t)t * 2048 + 1024 + c0) = w; } }
    }
    __syncthreads();
}

constexpr int NTASK_ML = 24 * ML_NVS, NTASK_HY0 = 512, NTASK_HY1 = 512, NTASK_S5 = 768, NTASK_CV = CVT_ALL - CVT_EARLY, NTASK_MIX = NTASK_ML + NTASK_HY0 + NTASK_HY1 + NTASK_S5, NTASK_D = NTASK_MIX + NTASK_CV + CVT_WIN;
__device__ __forceinline__ void mixers_phase(const Args& a, int l, unsigned char* lds, int coff, int mask = 15) {
    unsigned* ctr = (unsigned*)(a.ws + WS_CTR) + l * 64 + coff;
    volatile int* slot = (volatile int*)(lds + LDS_BYTES - 64);
    for (;;) {
        __syncthreads();
        if (launder_tid() == 0) *slot = (int)atomicAdd(ctr, 1u);
        __syncthreads();
        int task = *slot;
        if (task >= NTASK_D + (PROBE == 21 ? NTASK_S5 : 0)) break;
        if (PROBE == 21 && task >= NTASK_D) task -= NTASK_S5 + NTASK_CV + CVT_WIN;
        const int cls = task < NTASK_ML ? 1 : (task < NTASK_ML + NTASK_HY0 + NTASK_HY1 ? 2 : (task < NTASK_MIX ? 4 : 8));
        if (!(mask & cls)) continue;
        if (task < NTASK_ML) mlstm_task(a, task, lds);
        else if (task < NTASK_ML + NTASK_HY0) hyena_task<16384, 1>(a, l, task - NTASK_ML, lds);
        else if (task < NTASK_ML + NTASK_HY0 + NTASK_HY1) hyena_task<4096, 2>(a, l, task - NTASK_ML - NTASK_HY0, lds);
        else if (task < NTASK_MIX) s5_l3_task(a, l, task - (NTASK_ML + NTASK_HY0 + NTASK_HY1), lds);
        else if (task < NTASK_MIX + NTASK_CV) { __syncthreads(); convert_tile(a, l, CVT_EARLY + (task - NTASK_MIX), (float*)lds); }
        else if (l + 1 < NLAYER) { __syncthreads(); convert_tile(a, l + 1, task - NTASK_MIX - NTASK_CV, (float*)lds); }
    }
    __syncthreads();
}

#define LAS __attribute__((address_space(3)))

#define XB_TMO      128
#define XB_XCNT(j)  (256  + 64 * (j))
#define XB_XSUB(j)  (1280 + 64 * (j))
#define XB_XGEN(j)  (2304 + 64 * (j))
#define XB_TOP      3328
#define XB_TOPGEN   3392
#define XCD_BAR_WORDS 3456
#define XB_SPIN_CAP (1u << 18)

__device__ __forceinline__ unsigned xb_ld(unsigned* p)              { return __hip_atomic_load(p, __ATOMIC_RELAXED, __HIP_MEMORY_SCOPE_AGENT); }
__device__ __forceinline__ unsigned xb_add(unsigned* p, unsigned v) { return __hip_atomic_fetch_add(p, v, __ATOMIC_RELAXED, __HIP_MEMORY_SCOPE_AGENT); }
__device__ __forceinline__ unsigned xb_xcc_id() { return (unsigned)__builtin_amdgcn_s_getreg((3 << 11) | 20) & 0xFu; }
#define XB_SPIN(cond, bar) do { unsigned _sp = 0; while (cond) { __builtin_amdgcn_s_sleep(1); \
    if ((++_sp & 255u) == 0u) { if (xb_ld(&(bar)[XB_TMO])) break; if (_sp > XB_SPIN_CAP) { atomicAdd(&(bar)[XB_TMO], 1u); break; } } } } while (0)

struct XcdBarrier {
    unsigned* bar; unsigned x;
    volatile LAS unsigned* st;
};

__device__ __forceinline__ XcdBarrier xcd_barrier_post(unsigned* bar, volatile LAS unsigned* st) {
    XcdBarrier b; b.bar = bar; b.x = xb_xcc_id(); b.st = st;
    if (threadIdx.x == 0) (void)xb_add(&bar[XB_XCNT(b.x)], 1u);
    return b;
}
__device__ __forceinline__ void xcd_barrier_complete(unsigned* bar, unsigned x, unsigned& nloc, unsigned& nx) {
    const unsigned G = gridDim.x * gridDim.y * gridDim.z;
    unsigned sum, cnt, mine, sp = 0u;
    for (;;) {
        sum = 0u; cnt = 0u; mine = 0u;
#pragma unroll
        for (unsigned j = 0; j < 16; ++j) { const unsigned c = xb_ld(&bar[XB_XCNT(j)]); sum += c; cnt += (c > 0u) ? 1u : 0u; mine = (j == x) ? c : mine; }
        if (sum == G) break;
        __builtin_amdgcn_s_sleep(1);
        if ((++sp & 255u) == 0u) { if (xb_ld(&bar[XB_TMO])) break; if (sp > XB_SPIN_CAP) { atomicAdd(&bar[XB_TMO], 1u); break; } }
    }
    nloc = mine > 0u ? mine : 1u; nx = cnt > 0u ? cnt : 1u;
}

__device__ __forceinline__ void xcd_barrier(const XcdBarrier& b) {
    asm volatile("s_waitcnt vmcnt(0)" ::: "memory");
    __syncthreads();
    if (threadIdx.x == 0) {
        unsigned* bar = b.bar;
        __builtin_amdgcn_s_waitcnt(0);
        unsigned nloc = b.st[0], nx = b.st[1];
        if (nloc == 0u) { xcd_barrier_complete(bar, b.x, nloc, nx); b.st[0] = nloc; b.st[1] = nx; }
        const unsigned old = xb_add(&bar[XB_XSUB(b.x)], 1u);
        const unsigned gen = old / nloc;
        if (old + 1u == (gen + 1u) * nloc) {
            __builtin_amdgcn_fence(__ATOMIC_RELEASE, "agent");
            asm volatile("s_waitcnt vmcnt(0)" ::: "memory");
            const unsigned og = xb_add(&bar[XB_TOP], 1u);
            const unsigned tg = og / nx;
            if (og + 1u == (tg + 1u) * nx) xb_add(&bar[XB_TOPGEN], 1u);
            else XB_SPIN(xb_ld(&bar[XB_TOPGEN]) == tg, bar);
            __builtin_amdgcn_fence(__ATOMIC_ACQUIRE, "agent");
            xb_add(&bar[XB_XGEN(b.x)], 1u);
            asm volatile("s_waitcnt vmcnt(0)" ::: "memory");
        } else {
            XB_SPIN(xb_ld(&bar[XB_XGEN(b.x)]) == gen, bar);
            __builtin_amdgcn_fence(__ATOMIC_ACQUIRE, "agent");
            asm volatile("s_waitcnt vmcnt(0)" ::: "memory");
        }
    }
    __syncthreads();
}


__device__ __forceinline__ Args load_args() {
#if defined(__HIP_DEVICE_COMPILE__)
    unsigned long long p = (unsigned long long)__builtin_amdgcn_kernarg_segment_ptr();
    asm volatile("" : "+s"(p));
    return *(const __attribute__((address_space(4))) Args*)p;
#else
    return Args{};
#endif
}
#ifndef PROBE
#define PROBE 0
#endif
#define GREP(body) do { _Pragma("unroll 1") for (int rep_ = 0; rep_ < (PROBE == 1 ? 2 : 1); ++rep_) { body } } while (0)
constexpr int PH_PER_LAYER = 11, PH_TOTAL = NLAYER * PH_PER_LAYER + 1;
__global__ void __launch_bounds__(NT, 2) mk_fwd(Args a_in) {
    extern __shared__ __attribute__((aligned(16))) unsigned char lds[];
    cg::grid_group grid = cg::this_grid();
    PG8_LAS unsigned char* gl = (PG8_LAS unsigned char*)lds;
    const int lo = a_in.ph_lo, hi = a_in.ph_hi;
    const int G = (int)gridDim.x, bx = (int)blockIdx.x;
    volatile LAS unsigned* xst = (volatile LAS unsigned*)((PG8_LAS unsigned char*)lds + (LDS_BYTES - 32));
    if (threadIdx.x < 2) xst[threadIdx.x] = 0u;
    __syncthreads();
    const XcdBarrier xbar = xcd_barrier_post((unsigned*)(a_in.ws + WS_CTR + 4096), xst);
#define RUN(id) ((id) >= lo && (id) < hi)
#define SEAM(id) do { if ((id) >= lo && (id) + 1 < hi) { if ((id) == 0) grid.sync(); else xcd_barrier(xbar); } } while (0)
#pragma unroll 1
    for (int l = 0; l < NLAYER; ++l) {
        const int b = l * PH_PER_LAYER;
        if (RUN(b + 0)) { const Args a = load_args(); unsigned char* wb = a.ws + WS_WB; (void)wb; if (l == 0) rows_phase<0>(a, 0, lds); else rows_phase<2>(a, l - 1, lds); convert_weights(a, l, lds); h2_phase(a, l); }
        SEAM(b + 0);
        if (RUN(b + 1)) { const Args a = load_args(); unsigned char* wb = a.ws + WS_WB; (void)wb; pg8::Gemm g{(const bf16_t*)(a.ws + WS_H), (const bf16_t*)(wb + WB_WIN), TOK, NP, DM}; pg8::StaticOrder S; S.init(TOK, NP, G, launder_bid());
            pg8::EpiBf16X<0> E{(bf16_t*)(a.ws + WS_P), NP}; GREP(pg8::gemm_phase(gl, g, S, E);); }
        SEAM(b + 1);
#if PROBE == 2
        if (RUN(b + 2)) { const Args a = load_args(); gate_local_phase(a); conv_phase(a, l, lds); s5_l1_phase(a, l, lds); grid.sync(); sloc_phase(a); hf_phase(a, l, lds); grid.sync(); mixers_phase(a, l, lds, 16); grid.sync(); }
#endif
#if PROBE == 5 || PROBE == 7
        if (RUN(b + 2)) { const Args a = load_args(); unsigned char* wb = a.ws + WS_WB; (void)wb; gate_local_phase(a); conv_phase(a, l, lds); s5_l1_phase(a, l, lds); grid.sync(); sloc_phase(a); hf_phase(a, l, lds); grid.sync();
#if PROBE == 5
            mixers_phase(a, l, lds, 16, 2); grid.sync();
#endif
        }
#endif
        if (RUN(b + 2)) { const Args a = load_args(); unsigned char* wb = a.ws + WS_WB; (void)wb; gate_local_phase(a); conv_phase(a, l, lds); s5_l1_phase(a, l, lds);
#if PROBE == 10
            conv_phase(a, l, lds);
#elif PROBE == 12
            s5_l1_phase(a, l, lds);
#elif PROBE == 14
            gate_local_phase(a);
#endif
        }
        SEAM(b + 2);
        if (RUN(b + 3)) { const Args a = load_args(); unsigned char* wb = a.ws + WS_WB; (void)wb; sloc_phase(a); hf_phase(a, l, lds);
#if PROBE == 11
            hf_phase(a, l, lds);
#elif PROBE == 13
            sloc_phase(a);
#endif
        }
        SEAM(b + 3);
        if (RUN(b + 4)) { const Args a = load_args(); mixers_phase(a, l, lds, 0); }
        SEAM(b + 4);
        if (RUN(b + 5)) { const Args a = load_args(); unsigned char* wb = a.ws + WS_WB; (void)wb; pg8::Gemm g{(const bf16_t*)(a.ws + WS_S5Y), (const bf16_t*)(wb + WB_GLU), TOK, 1024, 512}; pg8::StaticOrder S; S.init(TOK, 1024, G, launder_bid());
            pg8::EpiGlu E{(float*)(a.ws + WS_S5O), 512, a.in[22] + l * 1024}; GREP(pg8::gemm_phase(gl, g, S, E);); }
        SEAM(b + 5);
        if (RUN(b + 6)) { const Args a = load_args(); groupnorm_phase(a, l, lds); }
        SEAM(b + 6);
        if (RUN(b + 7)) { const Args a = load_args(); unsigned char* wb = a.ws + WS_WB; (void)wb; pg8::Gemm g{(const bf16_t*)(a.ws + WS_MIX), (const bf16_t*)(wb + WB_WOUT), TOK, DM, DM}; pg8::StaticOrder S; S.init(TOK, DM, G, launder_bid());
            pg8::EpiBf16X<0> E{(bf16_t*)(a.ws + WS_TMP), DM}; GREP(pg8::gemm_phase(gl, g, S, E);); }
        SEAM(b + 7);
        if (RUN(b + 8)) { const Args a = load_args(); rows_phase<1>(a, l, lds); }
        SEAM(b + 8);
        if (RUN(b + 9)) { const Args a = load_args(); unsigned char* wb = a.ws + WS_WB; (void)wb; pg8::Gemm g{(const bf16_t*)(a.ws + WS_H), (const bf16_t*)(wb + WB_W1), TOK, DFF, DM}; pg8::StaticOrder S; S.init(TOK, DFF, G, launder_bid());
            pg8::EpiBf16X<3> E{(bf16_t*)(a.ws + WS_HID), DFF}; GREP(pg8::gemm_phase(gl, g, S, E);); }
        SEAM(b + 9);
        if (RUN(b + 10)) { const Args a = load_args(); unsigned char* wb = a.ws + WS_WB; (void)wb; pg8::Gemm g{(const bf16_t*)(a.ws + WS_HID), (const bf16_t*)(wb + WB_W2), TOK, DM, DFF}; pg8::StaticOrder S; S.init(TOK, DM, G, launder_bid());
            pg8::EpiBf16X<0> E{(bf16_t*)(a.ws + WS_TMP), DM}; GREP(pg8::gemm_phase(gl, g, S, E);); }
        SEAM(b + 10);
    }
    if (RUN(PH_TOTAL - 1)) { const Args a = load_args(); rows_phase<2>(a, NLAYER - 1, lds); }
#undef RUN
#undef SEAM
}

#ifndef MK_NLAUNCH
#define MK_NLAUNCH 1
#endif
extern "C" void kernel_launch(void* const* d_in, const int* in_sizes, int n_in, void* d_out, int out_size, void* d_ws, size_t ws_size, hipStream_t stream) {
    static int grid = 0;
    if (grid == 0) {
        int dev = 0, cus = 0, per_cu = 0;
        if (hipGetDevice(&dev) != hipSuccess || hipDeviceGetAttribute(&cus, hipDeviceAttributeMultiprocessorCount, dev) != hipSuccess) { fprintf(stderr, "device query failed\n"); grid = -1; return; }
        if (hipFuncSetAttribute((const void*)mk_fwd, hipFuncAttributeMaxDynamicSharedMemorySize, LDS_BYTES) != hipSuccess) { fprintf(stderr, "hipFuncSetAttribute failed\n"); grid = -1; return; }
        if (hipOccupancyMaxActiveBlocksPerMultiprocessor(&per_cu, (const void*)mk_fwd, NT, LDS_BYTES) != hipSuccess || per_cu < 1) fprintf(stderr, "occupancy query says %d\n", per_cu);
        (void)hipGetLastError();
        grid = cus;
        if (ws_size < WS_END || n_in != 28) { fprintf(stderr, "workspace %zu < %zu or n_in %d\n", ws_size, (size_t)WS_END, n_in); grid = -1; return; }
    }
    if (grid < 0) return;
    if (hipMemsetAsync((char*)d_ws + WS_CTR, 0, 4096 + 16384, stream) != hipSuccess) { fprintf(stderr, "memset failed\n"); return; }
    Args a{};
    for (int i = 0; i < 28; ++i) a.in[i] = (const float*)d_in[i];
    a.out = (float*)d_out; a.ws = (unsigned char*)d_ws;
    if (MK_NLAUNCH == 1) {
        a.ph_lo = 0; a.ph_hi = PH_TOTAL;
        void* args[] = {&a};
        hipError_t e = hipLaunchCooperativeKernel((const void*)mk_fwd, dim3(grid), dim3(NT), args, LDS_BYTES, stream);
        if (e != hipSuccess) fprintf(stderr, "cooperative launch failed: %s (grid %d)\n", hipGetErrorString(e), grid);
    } else {
        for (int ph = 0; ph < PH_TOTAL; ++ph) { a.ph_lo = ph; a.ph_hi = ph + 1; hipLaunchKernelGGL(mk_fwd, dim3(grid), dim3(NT), LDS_BYTES, stream, a); }
    }
}
```
